# Optimizing an MI355X kernel written in HIP

```python
import math
import jax
import jax.numpy as jnp
from jax import lax
import numpy as np

D_MODEL = 2048
BATCH = 16
SEQ = 2048
DEPTH = 1

MLA_HEADS = 8
MLA_Q_RANK = 512
MLA_KV_RANK = 256
MLA_NOPE_DIM = 128
MLA_ROPE_DIM = 64
MLA_V_DIM = 128
ROPE_THETA = 10000.0
SWA_Q_HEADS = 16
SWA_KV_HEADS = 4
SWA_HEAD_DIM = 64
WINDOW = 128
BLOCK = 128
REL_BUCKETS = 32
REL_MAX_DIST = 128
N_BRANCHES = 2
N_EXPERTS = 64
TOP_K = 8
N_GROUPS = 8
TOPK_GROUPS = 4
EXPERT_FF = 512
SHARED_FF = 512
ROUTED_SCALE = 2.5
EXPERT_BLOCK = 256
ALPHA = (2 * DEPTH) ** 0.25
BETA = (8 * DEPTH) ** -0.25
LN_EPS = 1e-5
RMS_EPS = 1e-6

COL_SIZES = (MLA_Q_RANK, MLA_KV_RANK, MLA_ROPE_DIM, SWA_Q_HEADS * SWA_HEAD_DIM,
             SWA_KV_HEADS * SWA_HEAD_DIM, SWA_KV_HEADS * SWA_HEAD_DIM, N_BRANCHES * D_MODEL)
IN_COLS = sum(COL_SIZES)

kernel_name = "hybrid_mla_swa_gated_moe_deepnorm"


def layer_norm(x, g, b):
    xf = x.astype(jnp.float32)
    mu = jnp.mean(xf, -1, keepdims=True)
    var = jnp.mean(jnp.square(xf - mu), -1, keepdims=True)
    return ((xf - mu) * lax.rsqrt(var + LN_EPS) * g.astype(jnp.float32) + b.astype(jnp.float32)).astype(x.dtype)


def rms_norm(x, g):
    xf = x.astype(jnp.float32)
    return (xf * lax.rsqrt(jnp.mean(jnp.square(xf), -1, keepdims=True) + RMS_EPS) * g.astype(jnp.float32)).astype(x.dtype)


def rope(x, positions):
    d = x.shape[-1]
    inv = ROPE_THETA ** (-jnp.arange(0, d, 2, dtype=jnp.float32) / d)
    ang = positions.astype(jnp.float32)[..., None] * inv
    cos = jnp.cos(ang)[:, :, None, :]
    sin = jnp.sin(ang)[:, :, None, :]
    x1, x2 = jnp.split(x.astype(jnp.float32), 2, axis=-1)
    return jnp.concatenate([x1 * cos - x2 * sin, x1 * sin + x2 * cos], -1).astype(x.dtype)


def t5_bucket(dist):
    n = jnp.maximum(dist, 0)
    max_exact = REL_BUCKETS // 2
    large = max_exact + (jnp.log(jnp.maximum(n, 1).astype(jnp.float32) / max_exact)
                         / math.log(REL_MAX_DIST / max_exact) * (REL_BUCKETS - max_exact)).astype(jnp.int32)
    large = jnp.minimum(large, REL_BUCKETS - 1)
    return jnp.where(n < max_exact, n, large)


def causal_block_attention(q, k, v, scale):
    B, S, H, dk = q.shape
    nb = S // BLOCK
    qb = q.reshape(B, nb, BLOCK, H, dk).transpose(1, 0, 2, 3, 4)
    kpos = jnp.arange(S)

    def one_block(args):
        qi, i = args
        s = jnp.einsum('bqhd,bkhd->bhqk', qi, k, preferred_element_type=jnp.float32) * scale
        qpos = i * BLOCK + jnp.arange(BLOCK)
        s = jnp.where(kpos[None, :] <= qpos[:, None], s, -jnp.inf)
        p = jax.nn.softmax(s, axis=-1).astype(v.dtype)
        return jnp.einsum('bhqk,bkhd->bqhd', p, v)

    out = lax.map(one_block, (qb, jnp.arange(nb)))
    return out.transpose(1, 0, 2, 3, 4).reshape(B, S, H, v.shape[-1])


def swa_sink_attention(q, k, v, sinks, rel_table):
    B, S, HQ, dh = q.shape
    G = HQ // SWA_KV_HEADS
    nb = S // BLOCK
    qb = q.reshape(B, nb, BLOCK, SWA_KV_HEADS, G, dh)

    def band(t):
        tb = t.reshape(B, nb, BLOCK, SWA_KV_HEADS, dh)
        prev = jnp.pad(tb[:, :-1], ((0, 0), (1, 0), (0, 0), (0, 0), (0, 0)))
        return jnp.concatenate([prev, tb], axis=2)

    kb, vb = band(k), band(v)
    s = jnp.einsum('bnqhgd,bnkhd->bnhgqk', qb, kb, preferred_element_type=jnp.float32) * (dh ** -0.5)
    qi = jnp.arange(BLOCK)[:, None]
    kj = jnp.arange(2 * BLOCK)[None, :]
    dist = qi + BLOCK - kj
    bias = rel_table[t5_bucket(dist)].astype(jnp.float32)
    bias = bias.transpose(2, 0, 1).reshape(SWA_KV_HEADS, G, BLOCK, 2 * BLOCK)
    in_window = (dist >= 0) & (dist < WINDOW)
    has_prev = (jnp.arange(nb)[:, None, None] > 0) | (kj[None] >= BLOCK)
    mask = in_window[None] & has_prev
    s = jnp.where(mask[None, :, None, None], s + bias, -jnp.inf)
    sink = jnp.broadcast_to(sinks.astype(jnp.float32).reshape(SWA_KV_HEADS, G, 1, 1), s.shape[:-1] + (1,))
    p = jax.nn.softmax(jnp.concatenate([s, sink], axis=-1), axis=-1)[..., :-1].astype(v.dtype)
    o = jnp.einsum('bnhgqk,bnkhd->bnqhgd', p, vb)
    return o.reshape(B, S, HQ, dh)


def token_mixer(x, positions, w_in, b_gate, q_norm_g, kv_norm_g, w_uq, w_uk, w_uv,
                swa_sinks, rel_table, w_br_mla, w_br_swa, w_out):
    B, S, _ = x.shape
    proj = x @ w_in
    bounds = np.cumsum(COL_SIZES)[:-1].tolist()
    c_q, c_kv, k_r, q_s, k_s, v_s, gate = jnp.split(proj, bounds, axis=-1)

    q = (rms_norm(c_q, q_norm_g) @ w_uq).reshape(B, S, MLA_HEADS, MLA_NOPE_DIM + MLA_ROPE_DIM)
    q_nope, q_rope = jnp.split(q, [MLA_NOPE_DIM], axis=-1)
    c_kv = rms_norm(c_kv, kv_norm_g)
    k_nope = (c_kv @ w_uk).reshape(B, S, MLA_HEADS, MLA_NOPE_DIM)
    v_m = (c_kv @ w_uv).reshape(B, S, MLA_HEADS, MLA_V_DIM)
    k_rope = rope(k_r[:, :, None, :], positions)
    q_m = jnp.concatenate([q_nope, rope(q_rope, positions)], axis=-1)
    k_m = jnp.concatenate([k_nope, jnp.broadcast_to(k_rope, (B, S, MLA_HEADS, MLA_ROPE_DIM))], axis=-1)
    o_m = causal_block_attention(q_m, k_m, v_m, (MLA_NOPE_DIM + MLA_ROPE_DIM) ** -0.5)

    o_s = swa_sink_attention(q_s.reshape(B, S, SWA_Q_HEADS, SWA_HEAD_DIM),
                             k_s.reshape(B, S, SWA_KV_HEADS, SWA_HEAD_DIM),
                             v_s.reshape(B, S, SWA_KV_HEADS, SWA_HEAD_DIM),
                             swa_sinks, rel_table)

    y_m = o_m.reshape(B, S, -1) @ w_br_mla
    y_s = o_s.reshape(B, S, -1) @ w_br_swa
    g = jax.nn.sigmoid(gate.reshape(B, S, N_BRANCHES, D_MODEL) + b_gate)
    merged = g[:, :, 0] * y_m + g[:, :, 1] * y_s
    return merged @ w_out


def moe_ffn(x, w_router, router_bias, w_gate_up, w_down, w_shared_gate_up, w_shared_down):
    B, S, D = x.shape
    xt = x.reshape(-1, D)
    T = xt.shape[0]
    scores = jax.nn.sigmoid((xt @ w_router).astype(jnp.float32))
    sel = scores + router_bias.astype(jnp.float32)
    grp_score = lax.top_k(sel.reshape(T, N_GROUPS, -1), 2)[0].sum(-1)
    _, top_g = lax.top_k(grp_score, TOPK_GROUPS)
    gmask = jax.nn.one_hot(top_g, N_GROUPS).sum(-2) > 0
    emask = jnp.repeat(gmask, N_EXPERTS // N_GROUPS, axis=-1)
    _, top_e = lax.top_k(jnp.where(emask, sel, -jnp.inf), TOP_K)
    w = jnp.take_along_axis(scores, top_e, axis=-1)
    w = w / jnp.sum(w, -1, keepdims=True) * ROUTED_SCALE

    N = T * TOP_K
    NB = -(-N // EXPERT_BLOCK) + N_EXPERTS
    NP = NB * EXPERT_BLOCK
    flat_e = top_e.reshape(-1)
    order = jnp.argsort(flat_e)
    sorted_e = flat_e[order]
    gs = jnp.bincount(flat_e, length=N_EXPERTS)
    ps = (gs + EXPERT_BLOCK - 1) // EXPERT_BLOCK * EXPERT_BLOCK
    start = jnp.cumsum(gs) - gs
    pend = jnp.cumsum(ps)
    pstart = pend - ps
    dest = pstart[sorted_e] + jnp.arange(N) - start[sorted_e]
    row_tok = jnp.full((NP,), T, jnp.int32).at[dest].set((order // TOP_K).astype(jnp.int32))
    row_w = jnp.zeros((NP,), jnp.float32).at[dest].set(w.reshape(-1)[order])
    block_e = jnp.minimum(jnp.searchsorted(pend, jnp.arange(NB) * EXPERT_BLOCK, side='right'), N_EXPERTS - 1)
    x_pad = jnp.concatenate([xt, jnp.zeros((1, D), xt.dtype)], axis=0)

    def expert_block(args):
        toks, wts, e = args
        h = x_pad[toks] @ w_gate_up[e]
        hg, hu = jnp.split(h, 2, axis=-1)
        return ((jax.nn.silu(hg) * hu) @ w_down[e]) * wts[:, None].astype(xt.dtype)

    ys = lax.map(expert_block, (row_tok.reshape(NB, EXPERT_BLOCK), row_w.reshape(NB, EXPERT_BLOCK), block_e))
    routed = jax.ops.segment_sum(ys.reshape(NP, D), row_tok, num_segments=T + 1)[:T]

    sg, su = jnp.split(xt @ w_shared_gate_up, 2, axis=-1)
    shared = (jax.nn.silu(sg) * su) @ w_shared_down
    return (routed + shared).reshape(B, S, D)


def setup_inputs(seed: int = 0) -> dict:
    key = jax.random.key(seed)
    ks = iter(jax.random.split(key, 32))
    f32 = jnp.float32
    L, D = DEPTH, D_MODEL

    def nrm(shape, scale):
        return jax.random.normal(next(ks), shape, f32) * scale

    x = nrm((BATCH, SEQ, D), 1.0)
    positions = jnp.broadcast_to(jnp.arange(SEQ, dtype=jnp.int32), (BATCH, SEQ))
    col_scale = jnp.concatenate([jnp.full((c,), BETA if i == 5 else 1.0, f32) for i, c in enumerate(COL_SIZES)])
    w_in = nrm((L, D, IN_COLS), D ** -0.5) * col_scale
    b_gate = nrm((L, N_BRANCHES, D), 0.1)
    q_norm_g = 1.0 + nrm((L, MLA_Q_RANK), 0.01)
    kv_norm_g = 1.0 + nrm((L, MLA_KV_RANK), 0.01)
    w_uq = nrm((L, MLA_Q_RANK, MLA_HEADS * (MLA_NOPE_DIM + MLA_ROPE_DIM)), MLA_Q_RANK ** -0.5)
    w_uk = nrm((L, MLA_KV_RANK, MLA_HEADS * MLA_NOPE_DIM), MLA_KV_RANK ** -0.5)
    w_uv = nrm((L, MLA_KV_RANK, MLA_HEADS * MLA_V_DIM), MLA_KV_RANK ** -0.5 * BETA)
    swa_sinks = nrm((L, SWA_Q_HEADS), 0.5)
    rel_table = nrm((REL_BUCKETS, SWA_Q_HEADS), 0.5)
    w_br_mla = nrm((L, MLA_HEADS * MLA_V_DIM, D), (MLA_HEADS * MLA_V_DIM) ** -0.5)
    w_br_swa = nrm((L, SWA_Q_HEADS * SWA_HEAD_DIM, D), (SWA_Q_HEADS * SWA_HEAD_DIM) ** -0.5)
    w_out = nrm((L, D, D), D ** -0.5 * BETA)
    ln1_g = 1.0 + nrm((L, D), 0.01)
    ln1_b = nrm((L, D), 0.01)
    w_router = nrm((L, D, N_EXPERTS), D ** -0.5)
    router_bias = nrm((L, N_EXPERTS), 0.01)
    w_gate_up = nrm((L, N_EXPERTS, D, 2 * EXPERT_FF), D ** -0.5)
    w_down = nrm((L, N_EXPERTS, EXPERT_FF, D), EXPERT_FF ** -0.5 * BETA)
    w_shared_gate_up = nrm((L, D, 2 * SHARED_FF), D ** -0.5)
    w_shared_down = nrm((L, SHARED_FF, D), SHARED_FF ** -0.5 * BETA)
    ln2_g = 1.0 + nrm((L, D), 0.01)
    ln2_b = nrm((L, D), 0.01)
    return {"x": x, "positions": positions, "w_in": w_in, "b_gate": b_gate,
            "q_norm_g": q_norm_g, "kv_norm_g": kv_norm_g, "w_uq": w_uq, "w_uk": w_uk,
            "w_uv": w_uv, "swa_sinks": swa_sinks, "rel_table": rel_table,
            "w_br_mla": w_br_mla, "w_br_swa": w_br_swa, "w_out": w_out,
            "ln1_g": ln1_g, "ln1_b": ln1_b, "w_router": w_router, "router_bias": router_bias,
            "w_gate_up": w_gate_up, "w_down": w_down, "w_shared_gate_up": w_shared_gate_up,
            "w_shared_down": w_shared_down, "ln2_g": ln2_g, "ln2_b": ln2_b}


def reference(x, positions, w_in, b_gate, q_norm_g, kv_norm_g, w_uq, w_uk, w_uv, swa_sinks,
              rel_table, w_br_mla, w_br_swa, w_out, ln1_g, ln1_b, w_router, router_bias,
              w_gate_up, w_down, w_shared_gate_up, w_shared_down, ln2_g, ln2_b):
    h = x
    for l in range(DEPTH):
        mix = token_mixer(h, positions, w_in[l], b_gate[l], q_norm_g[l], kv_norm_g[l], w_uq[l],
                          w_uk[l], w_uv[l], swa_sinks[l], rel_table, w_br_mla[l], w_br_swa[l], w_out[l])
        h = layer_norm(ALPHA * h + mix, ln1_g[l], ln1_b[l])
        ffn = moe_ffn(h, w_router[l], router_bias[l], w_gate_up[l], w_down[l],
                      w_shared_gate_up[l], w_shared_down[l])
        h = layer_norm(ALPHA * h + ffn, ln2_g[l], ln2_b[l])
    return h
```

```cpp
#include <hip/hip_runtime.h>
#include <cstdint>
#include <cstdio>

typedef unsigned short bf16_t;
typedef short bf16x8 __attribute__((ext_vector_type(8)));
typedef float f32x16 __attribute__((ext_vector_type(16)));
typedef float f32x4 __attribute__((ext_vector_type(4)));
typedef unsigned u32x4 __attribute__((ext_vector_type(4)));
typedef unsigned u32x2 __attribute__((ext_vector_type(2)));

constexpr int NB = 16, SEQ = 2048, T = NB * SEQ, DM = 2048;
constexpr int QR = 512, KVR = 256, ROPE = 64, NOPE = 128, VD = 128, MH = 8, QKD = NOPE + ROPE;
constexpr int SQH = 16, SKH = 4, SHD = 64;
constexpr int NE = 64, TOPK = 8, FF = 512;
constexpr int NPROJ = 6656;
constexpr float ALPHA = 1.189207115002721f;
constexpr float LN_EPS = 1e-5f, RMS_EPS = 1e-6f;
constexpr float LOG2E = 1.4426950408889634f;
constexpr float MLA_QSCALE = 0.07216878364870322f * LOG2E;
constexpr float SWA_QSCALE = 0.125f * LOG2E;
constexpr int MAXTILES = 1216;
constexpr int NSLOT = MAXTILES * 256;

constexpr size_t MiB = 1ull << 20;
constexpr size_t OFF_CTL = 0;
constexpr size_t OFF_ROPEC = 1 * MiB, OFF_ROPES = 5 * MiB;
constexpr size_t OFF_SSQ = 9 * MiB;
constexpr size_t OFF_TOPKW = 11 * MiB;
constexpr size_t OFF_TOPKE = 12 * MiB;
constexpr size_t OFF_POS = 13 * MiB;
constexpr size_t OFF_GIDX = 14 * MiB;
constexpr size_t OFF_DEST = 16 * MiB;
constexpr size_t OFF_TILEE = 18 * MiB;
constexpr size_t OFF_WR = 21 * MiB;
constexpr size_t OFF_LOGIT = 22 * MiB;
constexpr size_t OFF_WUQ = 30 * MiB;
constexpr size_t OFF_WUKV = 32 * MiB;
constexpr size_t OFF_WBR = 33 * MiB;
constexpr size_t OFF_WOUT = 41 * MiB;
constexpr size_t OFF_WIN = 49 * MiB;
constexpr size_t OFF_WDN = 75 * MiB;
constexpr size_t OFF_HB = 205 * MiB;
constexpr size_t OFF_ACT = 333 * MiB;
constexpr size_t OFF_WGU = 637 * MiB;
constexpr size_t OFF_HLO = 897 * MiB;
constexpr size_t OFF_XB = 1025 * MiB;
constexpr size_t OFF_CQ = 1153 * MiB;
constexpr size_t OFF_CKV = 1185 * MiB;
constexpr size_t OFF_QS = 1201 * MiB;
constexpr size_t OFF_KS = 1265 * MiB;
constexpr size_t OFF_VS = 1281 * MiB;
constexpr size_t OFF_KR = 1297 * MiB;
constexpr size_t OFF_RT = 1301 * MiB;
constexpr size_t OFF_G1 = 1429 * MiB;
constexpr size_t OFF_Q = 1557 * MiB;
constexpr size_t OFF_KN = 1653 * MiB;
constexpr size_t OFF_VM = 1717 * MiB;
constexpr size_t OFF_O = 1781 * MiB;
constexpr size_t OFF_MG = 1909 * MiB;
constexpr size_t OFF_HPRE = OFF_RT;
constexpr size_t OFF_Y = OFF_WGU;
constexpr size_t WS_NEED = 2037 * MiB;
static_assert(OFF_Y + (size_t)T * 9 * 2048 * 2 <= WS_NEED, "Y overlay");
constexpr int CW_CNT = 0, CW_TBASE = 128, CW_NT = 256;

__device__ __forceinline__ unsigned f2bf(float f) { unsigned u = __float_as_uint(f); return (u + 0x7fffu + ((u >> 16) & 1u)) >> 16; }
__device__ __forceinline__ float bf2f(bf16_t b) { return __uint_as_float((unsigned)b << 16); }
__device__ __forceinline__ int crow(int i, int h) { return (i & 3) + 8 * (i >> 2) + 4 * h; }
__device__ __forceinline__ float wave_sum(float v) {
#pragma unroll
    for (int o = 1; o < 64; o <<= 1) v += __shfl_xor(v, o);
    return v;
}
__device__ __forceinline__ float sigmoidf_(float x) { return 1.0f / (1.0f + __expf(-x)); }
#define MFMA32(a, b, c) __builtin_amdgcn_mfma_f32_32x32x16_bf16((a), (b), (c), 0, 0, 0)

__device__ const int T5_BUCKET[128] = {0, 1, 2, 3, 4, 5, 6, 7, 8, 9, 10, 11, 12, 13, 14, 15, 16, 16, 16, 17, 17, 18, 18, 18, 19, 19, 19, 20, 20, 20, 20, 21, 21, 21, 21, 22, 22, 22, 22, 22, 23, 23, 23, 23, 23, 23, 24, 24, 24, 24, 24, 24, 25, 25, 25, 25, 25, 25, 25, 26, 26, 26, 26, 26, 26, 26, 26, 27, 27, 27, 27, 27, 27, 27, 27, 27, 27, 28, 28, 28, 28, 28, 28, 28, 28, 28, 28, 29, 29, 29, 29, 29, 29, 29, 29, 29, 29, 29, 29, 30, 30, 30, 30, 30, 30, 30, 30, 30, 30, 30, 30, 30, 30, 31, 31, 31, 31, 31, 31, 31, 31, 31, 31, 31, 31, 31, 31, 31};
__device__ const double ROPE_INV[32] = {1.0, 0.7498942093324559, 0.5623413251903491, 0.4216965034285822, 0.31622776601683794, 0.23713737056616552, 0.1778279410038923, 0.1333521432163324, 0.09999999999999999, 0.07498942093324558, 0.056234132519034905, 0.042169650342858224, 0.03162277660168379, 0.023713737056616554, 0.01778279410038923, 0.013335214321633239, 0.01, 0.007498942093324559, 0.005623413251903491, 0.004216965034285822, 0.0031622776601683794, 0.002371373705661655, 0.0017782794100389228, 0.0013335214321633238, 0.001, 0.0007498942093324559, 0.000562341325190349, 0.00042169650342858224, 0.00031622776601683794, 0.00023713737056616554, 0.0001778279410038923, 0.0001333521432163324};

struct MapId { __device__ int src(int n) const { return n; } __device__ float cs(int) const { return 1.f; } };
struct MapWin {
    __device__ int src(int n) const {
        if (n < 768) return n;
        if (n < 2304) return n + 64;
        if (n < 6400) { const int j = (n - 2304) >> 8, c = (n - 2304) & 255; return c < 128 ? 2368 + 128 * j + c : 2368 + 2048 + 128 * j + (c - 128); }
        const int c = n - 6400; if (c < 32) return 768 + c; if (c >= 128 && c < 160) return 800 + (c - 128); return -1;
    }
    __device__ float cs(int n) const { return (n >= 768 && n < 1792) ? SWA_QSCALE : 1.f; }
};
struct MapWuq {
    __device__ int src(int n) const {
        if (n < 1024) return (n >> 7) * QKD + (n & 127);
        const int t = (n - 1024) >> 8, c = (n - 1024) & 255, half = c >> 7, hh = (c & 127) >> 5, i = c & 31;
        return (4 * t + hh) * QKD + NOPE + 32 * half + i;
    }
    __device__ float cs(int) const { return MLA_QSCALE; }
};
struct MapGU { __device__ int src(int n) const { const int p = n >> 8, c = n & 255; return c < 128 ? 128 * p + c : 512 + 128 * p + (c - 128); } __device__ float cs(int) const { return 1.f; } };

template <class Map>
__global__ __launch_bounds__(256) void k_wprep(const float* __restrict__ W, int K, int Nsrc, bf16_t* __restrict__ out, int Nout, int ldo, int koff, const float* __restrict__ kscale) {
    __shared__ float tile[32][33]; const Map map{};
    const int k0 = blockIdx.x * 32, n0 = blockIdx.y * 32, tx = threadIdx.x & 31, ty = threadIdx.x >> 5;
    const float* Wb = W + (size_t)blockIdx.z * K * Nsrc; bf16_t* ob = out + (size_t)blockIdx.z * Nout * ldo;
    const int sc = map.src(n0 + tx); const float cs = map.cs(n0 + tx);
#pragma unroll
    for (int i = 0; i < 4; ++i) { const int k = k0 + ty + 8 * i; float v = 0.f; if (sc >= 0) { v = Wb[(size_t)k * Nsrc + sc] * cs; if (kscale) v *= kscale[k]; } tile[ty + 8 * i][tx] = v; }
    __syncthreads();
#pragma unroll
    for (int i = 0; i < 4; ++i) { const int n = n0 + ty + 8 * i, k = k0 + tx; ob[(size_t)n * ldo + koff + k] = (bf16_t)f2bf(tile[tx][ty + 8 * i]); }
}
__global__ __launch_bounds__(256) void k_router_split(const float* __restrict__ w, bf16_t* __restrict__ hi, bf16_t* __restrict__ lo) {
    const int idx = blockIdx.x * 256 + threadIdx.x; if (idx >= NE * DM) return;
    const int e = idx / DM, k = idx % DM; const float v = w[(size_t)k * NE + e]; const unsigned h = f2bf(v); const float r = v - __uint_as_float(h << 16);
    hi[idx] = (bf16_t)h; lo[idx] = (bf16_t)f2bf(r);
}
__global__ __launch_bounds__(256) void k_cvt_x(const float* __restrict__ x, bf16_t* __restrict__ xb) {
    const size_t i = ((size_t)blockIdx.x * 256 + threadIdx.x) * 8; if (i >= (size_t)T * DM) return;
    const f32x4 a = *(const f32x4*)(x + i), b = *(const f32x4*)(x + i + 4);
    u32x4 o; o.x = f2bf(a.x) | (f2bf(a.y) << 16); o.y = f2bf(a.z) | (f2bf(a.w) << 16); o.z = f2bf(b.x) | (f2bf(b.y) << 16); o.w = f2bf(b.z) | (f2bf(b.w) << 16);
    *(u32x4*)(xb + i) = o;
}
__global__ __launch_bounds__(256) void k_rope_table(const int* __restrict__ pos, float* __restrict__ rc, float* __restrict__ rs) {
    const int idx = blockIdx.x * 256 + threadIdx.x; if (idx >= T * 32) return;
    const int t = idx >> 5, i = idx & 31;
    const double a = (double)pos[t] * ROPE_INV[i];
    const double k = __builtin_rint(a * 0.15915494309189535);
    const double r = __builtin_fma(-k, 6.283185307179586, a) - k * 2.4492935982947064e-16;
    const float rf = (float)r;
    rc[idx] = __cosf(rf); rs[idx] = __sinf(rf);
}

struct TileInfo { int row0; int pn; const bf16_t* Bt; bool valid; };
struct ProbDense { const bf16_t* Bt; int ntn; int pad; __device__ TileInfo operator()(int b) const { TileInfo t; t.row0 = (b / ntn) * 128; t.pn = b % ntn; t.Bt = Bt; t.valid = true; return t; } };
struct ProbMoe { const bf16_t* Bt; size_t estride; const int* tile_e; int ntn; int pad;
    __device__ TileInfo operator()(int b) const { TileInfo t; t.row0 = (b / ntn) * 128; t.pn = b % ntn; const int e = tile_e[t.row0 >> 8]; t.valid = e >= 0; t.Bt = Bt + (size_t)(e < 0 ? 0 : e) * estride; return t; } };

template <class P, class Epi>
__global__ __launch_bounds__(256) void k_sgemm(const bf16_t* __restrict__ A, int lda, const int* __restrict__ gidx, int K, int ldb, P prob, Epi epi) {
    const TileInfo ti = prob(blockIdx.x); if (!ti.valid) return;
    const int wave = threadIdx.x >> 6, lane = threadIdx.x & 63, r = lane & 31, h = lane >> 5;
    const int row0 = ti.row0 + (wave >> 1) * 64, cb = (wave & 1) * 64;
    const bf16_t* ap[2]; const bf16_t* bp[4];
#pragma unroll
    for (int i = 0; i < 2; ++i) { const int row = row0 + 32 * i + r; const int ar = gidx ? gidx[row] : row; ap[i] = A + (size_t)ar * lda + 8 * h; }
#pragma unroll
    for (int j = 0; j < 4; ++j) { const int col = ti.pn * 256 + cb + 32 * (j & 1) + 128 * (j >> 1) + r; bp[j] = ti.Bt + (size_t)col * ldb + 8 * h; }
    f32x16 acc[2][4];
#pragma unroll
    for (int i = 0; i < 2; ++i)
#pragma unroll
        for (int j = 0; j < 4; ++j)
#pragma unroll
            for (int q = 0; q < 16; ++q) acc[i][j][q] = 0.f;
    for (int k = 0; k < K; k += 16) {
        if (Epi::HAS_MID && k == (K >> 1)) {
#pragma unroll
            for (int i = 0; i < 2; ++i)
#pragma unroll
                for (int q = 0; q < 16; ++q)
#pragma unroll
                    for (int jj = 0; jj < 2; ++jj) { float m0 = acc[i][jj][q], m1 = acc[i][jj + 2][q]; epi.mid(row0 + 32 * i + crow(q, h), ti.pn, cb + 32 * jj + r, m0, m1); acc[i][jj][q] = m0; acc[i][jj + 2][q] = m1; }
        }
        bf16x8 a[2], b[4];
#pragma unroll
        for (int i = 0; i < 2; ++i) a[i] = *(const bf16x8*)(ap[i] + k);
#pragma unroll
        for (int j = 0; j < 4; ++j) b[j] = *(const bf16x8*)(bp[j] + k);
#pragma unroll
        for (int i = 0; i < 2; ++i)
#pragma unroll
            for (int j = 0; j < 4; ++j) acc[i][j] = MFMA32(a[i], b[j], acc[i][j]);
    }
#pragma unroll
    for (int i = 0; i < 2; ++i)
#pragma unroll
        for (int q = 0; q < 16; ++q)
#pragma unroll
            for (int jj = 0; jj < 2; ++jj) epi(row0 + 32 * i + crow(q, h), ti.pn, cb + 32 * jj + r, acc[i][jj][q], acc[i][jj + 2][q]);
}

struct EpiProj {
    static constexpr bool HAS_MID = false;
    bf16_t *CQ, *CKV, *QS, *KS, *VS, *KR, *RT, *G1; const float* bgate; const float *rc, *rs;
    __device__ void mid(int, int, int, float&, float&) const {}
    __device__ void operator()(int row, int pn, int c, float v0, float v1) const {
        const size_t ro = (size_t)row;
        if (pn < 2) { CQ[ro * 512 + pn * 256 + c] = (bf16_t)f2bf(v0); CQ[ro * 512 + pn * 256 + 128 + c] = (bf16_t)f2bf(v1); }
        else if (pn == 2) { CKV[ro * 256 + c] = (bf16_t)f2bf(v0); CKV[ro * 256 + 128 + c] = (bf16_t)f2bf(v1); }
        else if (pn < 7) { QS[ro * 1024 + (pn - 3) * 256 + c] = (bf16_t)f2bf(v0); QS[ro * 1024 + (pn - 3) * 256 + 128 + c] = (bf16_t)f2bf(v1); }
        else if (pn == 7) { KS[ro * 256 + c] = (bf16_t)f2bf(v0); KS[ro * 256 + 128 + c] = (bf16_t)f2bf(v1); }
        else if (pn == 8) { VS[ro * 256 + c] = (bf16_t)f2bf(v0); VS[ro * 256 + 128 + c] = (bf16_t)f2bf(v1); }
        else if (pn < 25) { const int col = (pn - 9) * 128 + c; const float g0 = sigmoidf_(v0 + bgate[col]), g1 = sigmoidf_(v1 + bgate[DM + col]);
            RT[ro * DM + col] = (bf16_t)f2bf(g0 / g1); G1[ro * DM + col] = (bf16_t)f2bf(g1); }
        else if (c < 32) { const float cs = rc[ro * 32 + c], sn = rs[ro * 32 + c]; KR[ro * 64 + c] = (bf16_t)f2bf(v0 * cs - v1 * sn); KR[ro * 64 + 32 + c] = (bf16_t)f2bf(v0 * sn + v1 * cs); }
    }
};
struct EpiQ {
    static constexpr bool HAS_MID = false;
    bf16_t* Q; const float* ssq; const float *rc, *rs;
    __device__ void mid(int, int, int, float&, float&) const {}
    __device__ void operator()(int row, int pn, int c, float v0, float v1) const {
        const float* sp = ssq + (size_t)row * 12; float s = 0.f;
#pragma unroll
        for (int i = 0; i < 8; ++i) s += sp[i];
        const float rsc = 1.0f / sqrtf(s * (1.0f / QR) + RMS_EPS); v0 *= rsc; v1 *= rsc;
        bf16_t* q = Q + (size_t)row * (MH * QKD);
        if (pn < 4) { q[(2 * pn) * QKD + c] = (bf16_t)f2bf(v0); q[(2 * pn + 1) * QKD + c] = (bf16_t)f2bf(v1); }
        else { const int head = 4 * (pn - 4) + (c >> 5), i = c & 31; const float cs = rc[(size_t)row * 32 + i], sn = rs[(size_t)row * 32 + i];
            q[head * QKD + NOPE + i] = (bf16_t)f2bf(v0 * cs - v1 * sn); q[head * QKD + NOPE + 32 + i] = (bf16_t)f2bf(v0 * sn + v1 * cs); }
    }
};
struct EpiKV {
    static constexpr bool HAS_MID = false;
    bf16_t *KN, *VM; const float* ssq;
    __device__ void mid(int, int, int, float&, float&) const {}
    __device__ void operator()(int row, int pn, int c, float v0, float v1) const {
        const float* sp = ssq + (size_t)row * 12 + 8; const float s = (sp[0] + sp[1]) + (sp[2] + sp[3]);
        const float rsc = 1.0f / sqrtf(s * (1.0f / KVR) + RMS_EPS); v0 *= rsc; v1 *= rsc;
        bf16_t* o = (pn < 4 ? KN : VM) + (size_t)row * 1024 + (pn & 3) * 256;
        o[c] = (bf16_t)f2bf(v0); o[128 + c] = (bf16_t)f2bf(v1);
    }
};
struct EpiMerge {
    static constexpr bool HAS_MID = true;
    const bf16_t *RT, *G1; bf16_t* MG;
    __device__ void mid(int row, int pn, int c, float& v0, float& v1) const { const size_t o = (size_t)row * DM + pn * 256 + c; v0 *= bf2f(RT[o]); v1 *= bf2f(RT[o + 128]); }
    __device__ void operator()(int row, int pn, int c, float v0, float v1) const { const size_t o = (size_t)row * DM + pn * 256 + c; MG[o] = (bf16_t)f2bf(v0 * bf2f(G1[o])); MG[o + 128] = (bf16_t)f2bf(v1 * bf2f(G1[o + 128])); }
};
struct EpiOut {
    static constexpr bool HAS_MID = false;
    const float* x; float* hpre;
    __device__ void mid(int, int, int, float&, float&) const {}
    __device__ void operator()(int row, int pn, int c, float v0, float v1) const { const size_t o = (size_t)row * DM + pn * 256 + c; hpre[o] = ALPHA * x[o] + v0; hpre[o + 128] = ALPHA * x[o + 128] + v1; }
};
struct EpiGU {
    static constexpr bool HAS_MID = false;
    bf16_t* ACT;
    __device__ void mid(int, int, int, float&, float&) const {}
    __device__ void operator()(int row, int pn, int c, float v0, float v1) const { const float s = v0 / (1.0f + __expf(-v0)); ACT[(size_t)row * FF + pn * 128 + c] = (bf16_t)f2bf(s * v1); }
};
struct EpiDown {
    static constexpr bool HAS_MID = false;
    bf16_t* Y; const int* dest;
    __device__ void mid(int, int, int, float&, float&) const {}
    __device__ void operator()(int row, int pn, int c, float v0, float v1) const { const int d = dest[row]; if (d < 0) return; bf16_t* y = Y + (size_t)d * DM + pn * 256 + c; y[0] = (bf16_t)f2bf(v0); y[128] = (bf16_t)f2bf(v1); }
};

__global__ __launch_bounds__(256) void k_ssq(const bf16_t* __restrict__ CQ, const bf16_t* __restrict__ CKV, float* __restrict__ ssq) {
    const int row = blockIdx.x * 4 + (threadIdx.x >> 6), lane = threadIdx.x & 63;
    float s = 0.f;
    { const bf16x8 v = *(const bf16x8*)(CQ + (size_t)row * 512 + lane * 8);
#pragma unroll
      for (int j = 0; j < 8; ++j) { const float f = bf2f((bf16_t)v[j]); s += f * f; } }
    s = wave_sum(s);
    float s2 = 0.f;
    { const bf16_t* p = CKV + (size_t)row * 256 + lane * 4;
#pragma unroll
      for (int j = 0; j < 4; ++j) { const float f = bf2f(p[j]); s2 += f * f; } }
    s2 = wave_sum(s2);
    if (lane < 12) ssq[(size_t)row * 12 + lane] = lane == 0 ? s : (lane == 8 ? s2 : 0.f);
}

__device__ __forceinline__ bf16x8 pack8(const f32x16& x, int s) {
    bf16x8 p;
#pragma unroll
    for (int j = 0; j < 8; ++j) p[j] = (short)f2bf(x[8 * s + j]);
    return p;
}
__global__ __launch_bounds__(256) void k_mla(const bf16_t* __restrict__ Q, const bf16_t* __restrict__ KN, const bf16_t* __restrict__ KR, const bf16_t* __restrict__ VM, bf16_t* __restrict__ O) {
    const int wave = threadIdx.x >> 6, lane = threadIdx.x & 63, r = lane & 31, h = lane >> 5;
    const int u = blockIdx.x * 4 + wave; const int qblk = 63 - (u >> 7), bh = u & 127, b = bh >> 3, hd = bh & 7;
    const size_t tb = (size_t)b * SEQ; const int q0 = qblk * 32;
    bf16x8 qf[12];
#pragma unroll
    for (int ks = 0; ks < 12; ++ks) qf[ks] = *(const bf16x8*)(Q + ((tb + q0 + r) * MH + hd) * QKD + 16 * ks + 8 * h);
    float m = -1e30f, l = 0.f; f32x16 ot[4];
#pragma unroll
    for (int d = 0; d < 4; ++d)
#pragma unroll
        for (int i = 0; i < 16; ++i) ot[d][i] = 0.f;
    for (int kb = 0; kb <= qblk; ++kb) {
        f32x16 x;
#pragma unroll
        for (int i = 0; i < 16; ++i) x[i] = 0.f;
        const size_t krow_ = tb + 32 * kb + r;
#pragma unroll
        for (int ks = 0; ks < 8; ++ks) { const bf16x8 kf = *(const bf16x8*)(KN + (krow_ * MH + hd) * NOPE + 16 * ks + 8 * h); x = MFMA32(kf, qf[ks], x); }
#pragma unroll
        for (int ks = 0; ks < 4; ++ks) { const bf16x8 kf = *(const bf16x8*)(KR + krow_ * ROPE + 16 * ks + 8 * h); x = MFMA32(kf, qf[8 + ks], x); }
        if (kb == qblk) {
#pragma unroll
            for (int i = 0; i < 16; ++i) if (crow(i, h) > r) x[i] = -1e30f;
        }
        float rm = x[0];
#pragma unroll
        for (int i = 1; i < 16; ++i) rm = fmaxf(rm, x[i]);
        rm = fmaxf(rm, __shfl_xor(rm, 32));
        const float mn = fmaxf(m, rm), al = exp2f(m - mn); m = mn;
        float ps = 0.f;
#pragma unroll
        for (int i = 0; i < 16; ++i) { x[i] = exp2f(x[i] - m); ps += x[i]; }
        l = l * al + ps;
#pragma unroll
        for (int d = 0; d < 4; ++d)
#pragma unroll
            for (int i = 0; i < 16; ++i) ot[d][i] *= al;
#pragma unroll
        for (int s = 0; s < 2; ++s) {
            const bf16x8 pa = pack8(x, s);
#pragma unroll
            for (int d = 0; d < 4; ++d) {
                bf16x8 vf;
#pragma unroll
                for (int j = 0; j < 8; ++j) { const int key = 32 * kb + 16 * s + 8 * (j >> 2) + 4 * h + (j & 3); vf[j] = (short)VM[((tb + key) * MH + hd) * VD + 32 * d + r]; }
                ot[d] = MFMA32(vf, pa, ot[d]);
            }
        }
    }
    l += __shfl_xor(l, 32); const float inv = 1.0f / l;
    bf16_t* o = O + (tb + q0 + r) * DM + hd * VD;
#pragma unroll
    for (int d = 0; d < 4; ++d)
#pragma unroll
        for (int i = 0; i < 16; ++i) o[32 * d + crow(i, h)] = (bf16_t)f2bf(ot[d][i] * inv);
}
__global__ __launch_bounds__(256) void k_swa(const bf16_t* __restrict__ QS, const bf16_t* __restrict__ KS, const bf16_t* __restrict__ VS, const float* __restrict__ sinks, const float* __restrict__ rel, bf16_t* __restrict__ O) {
    const int wave = threadIdx.x >> 6, lane = threadIdx.x & 63, r = lane & 31, h = lane >> 5;
    const int u = blockIdx.x * 4 + wave; const int qblk = u & 63, hq = (u >> 6) & 15, b = u >> 10, kvh = hq >> 2;
    const size_t tb = (size_t)b * SEQ; const int q0 = qblk * 32;
    bf16x8 qf[4];
#pragma unroll
    for (int ks = 0; ks < 4; ++ks) qf[ks] = *(const bf16x8*)(QS + ((tb + q0 + r) * SQH + hq) * SHD + 16 * ks + 8 * h);
    float m = sinks[hq] * LOG2E, l = (h == 0) ? 1.f : 0.f; f32x16 ot[2];
#pragma unroll
    for (int d = 0; d < 2; ++d)
#pragma unroll
        for (int i = 0; i < 16; ++i) ot[d][i] = 0.f;
    const int kb0 = qblk >= 4 ? qblk - 4 : 0;
    for (int kb = kb0; kb <= qblk; ++kb) {
        f32x16 x;
#pragma unroll
        for (int i = 0; i < 16; ++i) x[i] = 0.f;
        const size_t krow_ = tb + 32 * kb + r;
#pragma unroll
        for (int ks = 0; ks < 4; ++ks) { const bf16x8 kf = *(const bf16x8*)(KS + (krow_ * SKH + kvh) * SHD + 16 * ks + 8 * h); x = MFMA32(kf, qf[ks], x); }
#pragma unroll
        for (int i = 0; i < 16; ++i) { const int dist = (q0 + r) - (32 * kb + crow(i, h)); const bool ok = dist >= 0 && dist < 128;
            const float bias = rel[T5_BUCKET[ok ? dist : 0] * SQH + hq] * LOG2E; x[i] = ok ? x[i] + bias : -1e30f; }
        float rm = x[0];
#pragma unroll
        for (int i = 1; i < 16; ++i) rm = fmaxf(rm, x[i]);
        rm = fmaxf(rm, __shfl_xor(rm, 32));
        const float mn = fmaxf(m, rm), al = exp2f(m - mn); m = mn;
        float ps = 0.f;
#pragma unroll
        for (int i = 0; i < 16; ++i) { x[i] = exp2f(x[i] - m); ps += x[i]; }
        l = l * al + ps;
#pragma unroll
        for (int d = 0; d < 2; ++d)
#pragma unroll
            for (int i = 0; i < 16; ++i) ot[d][i] *= al;
#pragma unroll
        for (int s = 0; s < 2; ++s) {
            const bf16x8 pa = pack8(x, s);
#pragma unroll
            for (int d = 0; d < 2; ++d) {
                bf16x8 vf;
#pragma unroll
                for (int j = 0; j < 8; ++j) { const int key = 32 * kb + 16 * s + 8 * (j >> 2) + 4 * h + (j & 3); vf[j] = (short)VS[((tb + key) * SKH + kvh) * SHD + 32 * d + r]; }
                ot[d] = MFMA32(vf, pa, ot[d]);
            }
        }
    }
    l += __shfl_xor(l, 32); const float inv = 1.0f / l;
    bf16_t* o = O + (tb + q0 + r) * DM + 1024 + hq * SHD;
#pragma unroll
    for (int d = 0; d < 2; ++d)
#pragma unroll
        for (int i = 0; i < 16; ++i) o[32 * d + crow(i, h)] = (bf16_t)f2bf(ot[d][i] * inv);
}

__global__ __launch_bounds__(256) void k_ln1(const float* __restrict__ hpre, const float* __restrict__ g, const float* __restrict__ bta, bf16_t* __restrict__ HB, bf16_t* __restrict__ HLO) {
    const int row = blockIdx.x * 4 + (threadIdx.x >> 6), lane = threadIdx.x & 63;
    const f32x4* xr = (const f32x4*)(hpre + (size_t)row * DM) + lane;
    f32x4 v[8]; float s = 0.f;
#pragma unroll
    for (int j = 0; j < 8; ++j) { v[j] = xr[64 * j]; s += (v[j].x + v[j].y) + (v[j].z + v[j].w); }
    const float mean = wave_sum(s) * (1.f / DM); float s2 = 0.f;
#pragma unroll
    for (int j = 0; j < 8; ++j) { v[j] = v[j] - mean; s2 += (v[j].x * v[j].x + v[j].y * v[j].y) + (v[j].z * v[j].z + v[j].w * v[j].w); }
    const float rstd = 1.0f / sqrtf(wave_sum(s2) * (1.f / DM) + LN_EPS);
#pragma unroll
    for (int j = 0; j < 8; ++j) {
        const int c = 4 * lane + 256 * j; const f32x4 gg = *(const f32x4*)(g + c), bb = *(const f32x4*)(bta + c);
        const f32x4 y = v[j] * rstd * gg + bb;
        unsigned hh[4], ll[4];
#pragma unroll
        for (int q = 0; q < 4; ++q) { hh[q] = f2bf(y[q]); ll[q] = f2bf(y[q] - __uint_as_float(hh[q] << 16)); }
        u32x2 oh, ol; oh.x = hh[0] | (hh[1] << 16); oh.y = hh[2] | (hh[3] << 16); ol.x = ll[0] | (ll[1] << 16); ol.y = ll[2] | (ll[3] << 16);
        *(u32x2*)(HB + (size_t)row * DM + c) = oh; *(u32x2*)(HLO + (size_t)row * DM + c) = ol;
    }
}
__global__ __launch_bounds__(256) void k_router(const bf16_t* __restrict__ HB, const bf16_t* __restrict__ HLO, const bf16_t* __restrict__ WH, const bf16_t* __restrict__ WL, float* __restrict__ logits) {
    const int wave = threadIdx.x >> 6, lane = threadIdx.x & 63, r = lane & 31, h = lane >> 5;
    const int row0 = (blockIdx.x * 4 + wave) * 32;
    const bf16_t* ah = HB + (size_t)(row0 + r) * DM + 8 * h; const bf16_t* al = HLO + (size_t)(row0 + r) * DM + 8 * h;
    f32x16 acc[2];
#pragma unroll
    for (int j = 0; j < 2; ++j)
#pragma unroll
        for (int i = 0; i < 16; ++i) acc[j][i] = 0.f;
    for (int k = 0; k < DM; k += 16) {
        const bf16x8 a_h = *(const bf16x8*)(ah + k), a_l = *(const bf16x8*)(al + k);
#pragma unroll
        for (int j = 0; j < 2; ++j) {
            const bf16x8 b_h = *(const bf16x8*)(WH + (size_t)(32 * j + r) * DM + 8 * h + k), b_l = *(const bf16x8*)(WL + (size_t)(32 * j + r) * DM + 8 * h + k);
            acc[j] = MFMA32(a_l, b_h, acc[j]); acc[j] = MFMA32(a_h, b_l, acc[j]); acc[j] = MFMA32(a_h, b_h, acc[j]);
        }
    }
#pragma unroll
    for (int j = 0; j < 2; ++j)
#pragma unroll
        for (int i = 0; i < 16; ++i) logits[(size_t)(row0 + crow(i, h)) * NE + 32 * j + r] = acc[j][i];
}
__global__ __launch_bounds__(256) void k_topk(const float* __restrict__ logits, const float* __restrict__ rbias, float* __restrict__ topw, int* __restrict__ tope, int* __restrict__ pos, unsigned* __restrict__ cnt) {
    const int t = blockIdx.x * 4 + (threadIdx.x >> 6), lane = threadIdx.x & 63;
    const float score = sigmoidf_(logits[(size_t)t * NE + lane]); const float sel = score + rbias[lane];
    float m1 = sel;
    m1 = fmaxf(m1, __shfl_xor(m1, 1)); m1 = fmaxf(m1, __shfl_xor(m1, 2)); m1 = fmaxf(m1, __shfl_xor(m1, 4));
    int i1 = (sel == m1) ? lane : 64;
    i1 = min(i1, __shfl_xor(i1, 1)); i1 = min(i1, __shfl_xor(i1, 2)); i1 = min(i1, __shfl_xor(i1, 4));
    float m2 = (lane == i1) ? -INFINITY : sel;
    m2 = fmaxf(m2, __shfl_xor(m2, 1)); m2 = fmaxf(m2, __shfl_xor(m2, 2)); m2 = fmaxf(m2, __shfl_xor(m2, 4));
    const float gs = m1 + m2; const int g = lane >> 3;
    int grank = 0;
#pragma unroll
    for (int gg = 0; gg < 8; ++gg) { const float o = __shfl(gs, 8 * gg); grank += (o > gs || (o == gs && gg < g)) ? 1 : 0; }
    const float selm = grank < 4 ? sel : -INFINITY;
    int rank = 0;
    for (int ll = 0; ll < 64; ++ll) { const float o = __shfl(selm, ll); rank += (o > selm || (o == selm && ll < lane)) ? 1 : 0; }
    const bool chosen = rank < TOPK;
    const float wsum = wave_sum(chosen ? score : 0.f);
    if (chosen) {
        topw[(size_t)t * TOPK + rank] = score / wsum * 2.5f; tope[(size_t)t * TOPK + rank] = lane;
        pos[(size_t)t * TOPK + rank] = (int)atomicAdd(cnt + CW_CNT + lane, 1u);
    }
}
__global__ __launch_bounds__(256) void k_prefix(unsigned* __restrict__ ctl, int* __restrict__ tile_e) {
    __shared__ int base[66];
    if (threadIdx.x == 0) { int acc = 0; for (int e = 0; e < NE; ++e) { base[e] = acc; acc += ((int)ctl[CW_CNT + e] + 255) >> 8; } base[64] = acc; base[65] = acc + T / 256;
        for (int e = 0; e < 66; ++e) ctl[CW_TBASE + e] = (unsigned)base[e]; ctl[CW_NT] = (unsigned)base[65]; }
    __syncthreads();
    for (int i = threadIdx.x; i < MAXTILES; i += 256) { int e = -1; if (i < base[65]) { e = 0; while (base[e + 1] <= i) ++e; } tile_e[i] = e; }
}
__global__ __launch_bounds__(256) void k_fill_slots(int* __restrict__ gidx, int* __restrict__ dest) {
    const int i = blockIdx.x * 256 + threadIdx.x; if (i < NSLOT) { gidx[i] = 0; dest[i] = -1; }
}
__global__ __launch_bounds__(256) void k_assign(const unsigned* __restrict__ ctl, const int* __restrict__ tope, const int* __restrict__ pos, int* __restrict__ gidx, int* __restrict__ dest) {
    const int i = blockIdx.x * 256 + threadIdx.x;
    if (i >= T * 9) return;
    const int t = i / 9, k = i % 9; int slot;
    if (k < 8) { const int e = tope[(size_t)t * 8 + k]; slot = (int)ctl[CW_TBASE + e] * 256 + pos[(size_t)t * 8 + k]; }
    else slot = (int)ctl[CW_TBASE + 64] * 256 + t;
    gidx[slot] = t; dest[slot] = i;
}
__global__ __launch_bounds__(256) void k_final(const bf16_t* __restrict__ HB, const bf16_t* __restrict__ Y, const float* __restrict__ topw, const float* __restrict__ g, const float* __restrict__ bta, float* __restrict__ out) {
    const int t = blockIdx.x * 4 + (threadIdx.x >> 6), lane = threadIdx.x & 63;
    float w[9];
#pragma unroll
    for (int k = 0; k < 8; ++k) w[k] = topw[(size_t)t * 8 + k];
    w[8] = 1.f;
    f32x4 v[8]; float s = 0.f;
#pragma unroll
    for (int j = 0; j < 8; ++j) {
        const int c = 4 * lane + 256 * j;
        const u32x2 hb = *(const u32x2*)(HB + (size_t)t * DM + c);
        f32x4 a; a.x = __uint_as_float(hb.x << 16) * ALPHA; a.y = __uint_as_float(hb.x & 0xffff0000u) * ALPHA; a.z = __uint_as_float(hb.y << 16) * ALPHA; a.w = __uint_as_float(hb.y & 0xffff0000u) * ALPHA;
#pragma unroll
        for (int k = 0; k < 9; ++k) {
            const u32x2 yb = *(const u32x2*)(Y + ((size_t)t * 9 + k) * DM + c);
            a.x += w[k] * __uint_as_float(yb.x << 16); a.y += w[k] * __uint_as_float(yb.x & 0xffff0000u); a.z += w[k] * __uint_as_float(yb.y << 16); a.w += w[k] * __uint_as_float(yb.y & 0xffff0000u);
        }
        v[j] = a; s += (a.x + a.y) + (a.z + a.w);
    }
    const float mean = wave_sum(s) * (1.f / DM); float s2 = 0.f;
#pragma unroll
    for (int j = 0; j < 8; ++j) { v[j] = v[j] - mean; s2 += (v[j].x * v[j].x + v[j].y * v[j].y) + (v[j].z * v[j].z + v[j].w * v[j].w); }
    const float rstd = 1.0f / sqrtf(wave_sum(s2) * (1.f / DM) + LN_EPS);
#pragma unroll
    for (int j = 0; j < 8; ++j) { const int c = 4 * lane + 256 * j; const f32x4 gg = *(const f32x4*)(g + c), bb = *(const f32x4*)(bta + c);
        *(f32x4*)(out + (size_t)t * DM + c) = v[j] * rstd * gg + bb; }
}

extern "C" void kernel_launch(void* const* d_in, const int* in_sizes, int n_in, void* d_out, int out_size, void* d_ws, size_t ws_size, hipStream_t stream) {
    if (n_in != 24 || out_size != T * DM || ws_size < WS_NEED) { fprintf(stderr, "kernel_launch: unexpected problem (n_in %d, out %d, ws %zu < %zu)\n", n_in, out_size, ws_size, (size_t)WS_NEED); return; }
    const float* x = (const float*)d_in[0]; const int* positions = (const int*)d_in[1]; const float* w_in = (const float*)d_in[2]; const float* b_gate = (const float*)d_in[3];
    const float* q_norm_g = (const float*)d_in[4]; const float* kv_norm_g = (const float*)d_in[5]; const float* w_uq = (const float*)d_in[6]; const float* w_uk = (const float*)d_in[7];
    const float* w_uv = (const float*)d_in[8]; const float* swa_sinks = (const float*)d_in[9]; const float* rel_table = (const float*)d_in[10]; const float* w_br_mla = (const float*)d_in[11];
    const float* w_br_swa = (const float*)d_in[12]; const float* w_out = (const float*)d_in[13]; const float* ln1_g = (const float*)d_in[14]; const float* ln1_b = (const float*)d_in[15];
    const float* w_router = (const float*)d_in[16]; const float* router_bias = (const float*)d_in[17]; const float* w_gate_up = (const float*)d_in[18]; const float* w_down = (const float*)d_in[19];
    const float* w_sgu = (const float*)d_in[20]; const float* w_sdn = (const float*)d_in[21]; const float* ln2_g = (const float*)d_in[22]; const float* ln2_b = (const float*)d_in[23];
    unsigned char* ws = (unsigned char*)d_ws; float* out = (float*)d_out;
    unsigned* ctl = (unsigned*)(ws + OFF_CTL);
    float* ropec = (float*)(ws + OFF_ROPEC); float* ropes = (float*)(ws + OFF_ROPES); float* ssq = (float*)(ws + OFF_SSQ);
    float* topw = (float*)(ws + OFF_TOPKW); int* tope = (int*)(ws + OFF_TOPKE); int* pos = (int*)(ws + OFF_POS); int* gidx = (int*)(ws + OFF_GIDX); int* dest = (int*)(ws + OFF_DEST); int* tile_e = (int*)(ws + OFF_TILEE);
    bf16_t* WRH = (bf16_t*)(ws + OFF_WR); bf16_t* WRL = WRH + NE * DM; float* logits = (float*)(ws + OFF_LOGIT);
    bf16_t* WUQ = (bf16_t*)(ws + OFF_WUQ); bf16_t* WUKV = (bf16_t*)(ws + OFF_WUKV); bf16_t* WBR = (bf16_t*)(ws + OFF_WBR); bf16_t* WOUT = (bf16_t*)(ws + OFF_WOUT); bf16_t* WIN = (bf16_t*)(ws + OFF_WIN);
    bf16_t* WDN = (bf16_t*)(ws + OFF_WDN); bf16_t* WGU = (bf16_t*)(ws + OFF_WGU);
    bf16_t* HB = (bf16_t*)(ws + OFF_HB); bf16_t* HLO = (bf16_t*)(ws + OFF_HLO); bf16_t* ACT = (bf16_t*)(ws + OFF_ACT); bf16_t* XB = (bf16_t*)(ws + OFF_XB);
    bf16_t* CQ = (bf16_t*)(ws + OFF_CQ); bf16_t* CKV = (bf16_t*)(ws + OFF_CKV); bf16_t* QS = (bf16_t*)(ws + OFF_QS); bf16_t* KS = (bf16_t*)(ws + OFF_KS); bf16_t* VS = (bf16_t*)(ws + OFF_VS); bf16_t* KR = (bf16_t*)(ws + OFF_KR);
    bf16_t* RT = (bf16_t*)(ws + OFF_RT); bf16_t* G1 = (bf16_t*)(ws + OFF_G1); bf16_t* Q = (bf16_t*)(ws + OFF_Q); bf16_t* KN = (bf16_t*)(ws + OFF_KN); bf16_t* VM = (bf16_t*)(ws + OFF_VM);
    bf16_t* O = (bf16_t*)(ws + OFF_O); bf16_t* MG = (bf16_t*)(ws + OFF_MG); float* HPRE = (float*)(ws + OFF_HPRE); bf16_t* Y = (bf16_t*)(ws + OFF_Y);

    (void)hipMemsetAsync(ws + OFF_CTL, 0, 1 * MiB, stream);
    hipLaunchKernelGGL(k_wprep<MapWin>, dim3(DM / 32, NPROJ / 32, 1), dim3(256), 0, stream, w_in, DM, 6464, WIN, NPROJ, DM, 0, (const float*)nullptr);
    hipLaunchKernelGGL(k_wprep<MapWuq>, dim3(QR / 32, 1536 / 32, 1), dim3(256), 0, stream, w_uq, QR, 1536, WUQ, 1536, QR, 0, q_norm_g);
    hipLaunchKernelGGL(k_wprep<MapId>, dim3(KVR / 32, 1024 / 32, 1), dim3(256), 0, stream, w_uk, KVR, 1024, WUKV, 1024, KVR, 0, kv_norm_g);
    hipLaunchKernelGGL(k_wprep<MapId>, dim3(KVR / 32, 1024 / 32, 1), dim3(256), 0, stream, w_uv, KVR, 1024, WUKV + 1024 * KVR, 1024, KVR, 0, kv_norm_g);
    hipLaunchKernelGGL(k_wprep<MapId>, dim3(1024 / 32, DM / 32, 1), dim3(256), 0, stream, w_br_mla, 1024, DM, WBR, DM, DM, 0, (const float*)nullptr);
    hipLaunchKernelGGL(k_wprep<MapId>, dim3(1024 / 32, DM / 32, 1), dim3(256), 0, stream, w_br_swa, 1024, DM, WBR, DM, DM, 1024, (const float*)nullptr);
    hipLaunchKernelGGL(k_wprep<MapId>, dim3(DM / 32, DM / 32, 1), dim3(256), 0, stream, w_out, DM, DM, WOUT, DM, DM, 0, (const float*)nullptr);
    hipLaunchKernelGGL(k_wprep<MapGU>, dim3(DM / 32, 1024 / 32, NE), dim3(256), 0, stream, w_gate_up, DM, 1024, WGU, 1024, DM, 0, (const float*)nullptr);
    hipLaunchKernelGGL(k_wprep<MapGU>, dim3(DM / 32, 1024 / 32, 1), dim3(256), 0, stream, w_sgu, DM, 1024, WGU + (size_t)NE * 1024 * DM, 1024, DM, 0, (const float*)nullptr);
    hipLaunchKernelGGL(k_wprep<MapId>, dim3(FF / 32, DM / 32, NE), dim3(256), 0, stream, w_down, FF, DM, WDN, DM, FF, 0, (const float*)nullptr);
    hipLaunchKernelGGL(k_wprep<MapId>, dim3(FF / 32, DM / 32, 1), dim3(256), 0, stream, w_sdn, FF, DM, WDN + (size_t)NE * DM * FF, DM, FF, 0, (const float*)nullptr);
    hipLaunchKernelGGL(k_router_split, dim3(NE * DM / 256), dim3(256), 0, stream, w_router, WRH, WRL);
    hipLaunchKernelGGL(k_cvt_x, dim3(T * DM / 8 / 256), dim3(256), 0, stream, x, XB);
    hipLaunchKernelGGL(k_rope_table, dim3(T * 32 / 256), dim3(256), 0, stream, positions, ropec, ropes);
    { EpiProj e{CQ, CKV, QS, KS, VS, KR, RT, G1, b_gate, ropec, ropes}; ProbDense p{WIN, NPROJ / 256, 0};
      hipLaunchKernelGGL((k_sgemm<ProbDense, EpiProj>), dim3((T / 128) * (NPROJ / 256)), dim3(256), 0, stream, XB, DM, (const int*)nullptr, DM, DM, p, e); }
    hipLaunchKernelGGL(k_ssq, dim3(T / 4), dim3(256), 0, stream, CQ, CKV, ssq);
    { EpiQ e{Q, ssq, ropec, ropes}; ProbDense p{WUQ, 1536 / 256, 0};
      hipLaunchKernelGGL((k_sgemm<ProbDense, EpiQ>), dim3((T / 128) * 6), dim3(256), 0, stream, CQ, QR, (const int*)nullptr, QR, QR, p, e); }
    { EpiKV e{KN, VM, ssq}; ProbDense p{WUKV, 8, 0};
      hipLaunchKernelGGL((k_sgemm<ProbDense, EpiKV>), dim3((T / 128) * 8), dim3(256), 0, stream, CKV, KVR, (const int*)nullptr, KVR, KVR, p, e); }
    hipLaunchKernelGGL(k_mla, dim3(NB * MH * 64 / 4), dim3(256), 0, stream, Q, KN, KR, VM, O);
    hipLaunchKernelGGL(k_swa, dim3(NB * SQH * 64 / 4), dim3(256), 0, stream, QS, KS, VS, swa_sinks, rel_table, O);
    { EpiMerge e{RT, G1, MG}; ProbDense p{WBR, 8, 0};
      hipLaunchKernelGGL((k_sgemm<ProbDense, EpiMerge>), dim3((T / 128) * 8), dim3(256), 0, stream, O, DM, (const int*)nullptr, DM, DM, p, e); }
    { EpiOut e{x, HPRE}; ProbDense p{WOUT, 8, 0};
      hipLaunchKernelGGL((k_sgemm<ProbDense, EpiOut>), dim3((T / 128) * 8), dim3(256), 0, stream, MG, DM, (const int*)nullptr, DM, DM, p, e); }
    hipLaunchKernelGGL(k_ln1, dim3(T / 4), dim3(256), 0, stream, HPRE, ln1_g, ln1_b, HB, HLO);
    hipLaunchKernelGGL(k_router, dim3(T / 128), dim3(256), 0, stream, HB, HLO, WRH, WRL, logits);
    hipLaunchKernelGGL(k_topk, dim3(T / 4), dim3(256), 0, stream, logits, router_bias, topw, tope, pos, ctl);
    hipLaunchKernelGGL(k_prefix, dim3(1), dim3(256), 0, stream, ctl, tile_e);
    hipLaunchKernelGGL(k_fill_slots, dim3(NSLOT / 256), dim3(256), 0, stream, gidx, dest);
    hipLaunchKernelGGL(k_assign, dim3(T * 9 / 256), dim3(256), 0, stream, ctl, tope, pos, gidx, dest);
    { EpiGU e{ACT}; ProbMoe p{WGU, (size_t)1024 * DM, tile_e, 4, 0};
      hipLaunchKernelGGL((k_sgemm<ProbMoe, EpiGU>), dim3(MAXTILES * 2 * 4), dim3(256), 0, stream, HB, DM, gidx, DM, DM, p, e); }
    { EpiDown e{Y, dest}; ProbMoe p{WDN, (size_t)DM * FF, tile_e, 8, 0};
      hipLaunchKernelGGL((k_sgemm<ProbMoe, EpiDown>), dim3(MAXTILES * 2 * 8), dim3(256), 0, stream, ACT, FF, (const int*)nullptr, FF, FF, p, e); }
    hipLaunchKernelGGL(k_final, dim3(T / 4), dim3(256), 0, stream, HB, Y, topw, ln2_g, ln2_b, out);
}
```

```cpp
#include <hip/hip_runtime.h>
#include <cstdint>
#include <cstdio>
#include <cstring>

typedef unsigned short bf16_t;
typedef short bf16x8 __attribute__((ext_vector_type(8)));
typedef float f32x16 __attribute__((ext_vector_type(16)));
typedef float f32x4 __attribute__((ext_vector_type(4)));
typedef unsigned u32x4 __attribute__((ext_vector_type(4)));
typedef unsigned u32x2 __attribute__((ext_vector_type(2)));

#ifndef CONV_SPLIT
#define CONV_SPLIT 192
#endif
#ifndef NE_GU0
#define NE_GU0 0
#endif
#ifndef CONV_DYNAMIC
#define CONV_DYNAMIC 0
#endif
constexpr int NB = 16, SEQ = 2048, T = NB * SEQ, DM = 2048;
constexpr int QR = 512, KVR = 256, ROPE = 64, NOPE = 128, VD = 128, MH = 8, QKD = NOPE + ROPE;
constexpr int SQH = 16, SKH = 4, SHD = 64;
constexpr int NE = 64, TOPK = 8, FF = 512;
constexpr int NPROJ = 6656;
constexpr float ALPHA = 1.189207115002721f;
constexpr float LN_EPS = 1e-5f, RMS_EPS = 1e-6f;
constexpr float LOG2E = 1.4426950408889634f;
constexpr float MLA_QSCALE = 0.07216878364870322f * LOG2E;
constexpr float SWA_QSCALE = 0.125f * LOG2E;
#ifndef MOE_FP8
#define MOE_FP8 1
#endif
#ifndef GATE_FP8
#define GATE_FP8 1
#endif
#ifndef PROJ_FP8
#define PROJ_FP8 1
#endif
#ifndef MERGE_FP8
#define MERGE_FP8 1
#endif
#ifndef MIX_FP8
#define MIX_FP8 1
#endif
#ifndef GATE8
#define GATE8 1
#endif
constexpr float G18_SCALE = 32.0f;
#ifndef Y_FP8
#define Y_FP8 1
#endif
constexpr float H8_SCALE = 4.0f, ACT_SCALE = 4.0f, W8_SCALE = 32.0f, Y_SCALE = 8.0f;
constexpr unsigned E8_ACTY = 0x80808080u  ;
static_assert(Y_SCALE == 8.0f && ACT_SCALE == 4.0f, "E8_ACTY encodes Y_SCALE / ACT_SCALE = 2");
constexpr unsigned E8_ACT = 0x7d7d7d7du  , E8_W = 0x7a7a7a7au  , E8_16 = 0x7b7b7b7bu  , E8_64 = 0x79797979u  ;
constexpr float O8_SCALE = 32.0f, MG8_SCALE = 32.0f, WOUT8_SCALE = 32.0f;
constexpr int MAXTILES = 1216;
constexpr int NSLOT = MAXTILES * 256;

constexpr size_t MiB = 1ull << 20;
constexpr size_t OFF_CTL = 0;
constexpr size_t OFF_ROPEC = 1 * MiB, OFF_ROPES = 5 * MiB;
constexpr size_t OFF_SSQ = 9 * MiB;
constexpr size_t OFF_TOPKW = 11 * MiB;
constexpr size_t OFF_DLIST = 12 * MiB;
constexpr size_t OFF_WR = 21 * MiB;
constexpr size_t OFF_LIST = 22 * MiB;
constexpr size_t OFF_WUQ = 30 * MiB;
constexpr size_t OFF_WUKV = 32 * MiB;
constexpr size_t OFF_WBR = 33 * MiB;
constexpr size_t OFF_WOUT = 41 * MiB;
constexpr size_t OFF_WIN = 49 * MiB;
constexpr size_t OFF_WDN = 75 * MiB;
constexpr size_t OFF_HB8 = 141 * MiB;
constexpr size_t OFF_HB = 205 * MiB;
constexpr size_t OFF_ACT = 333 * MiB;
constexpr size_t OFF_WGU = 637 * MiB;
constexpr size_t OFF_XB = 1025 * MiB;
constexpr size_t OFF_CQ = 1153 * MiB;
constexpr size_t OFF_CKV = 1185 * MiB;
constexpr size_t OFF_QS = 1201 * MiB;
constexpr size_t OFF_KS = 1265 * MiB;
constexpr size_t OFF_VS = 1281 * MiB;
constexpr size_t OFF_KR = 1297 * MiB;
constexpr size_t OFF_RT = 1301 * MiB;
constexpr size_t OFF_G1 = 1429 * MiB;
constexpr size_t OFF_Q = 1557 * MiB;
constexpr size_t OFF_KN = 1653 * MiB;
constexpr size_t OFF_VM = 1717 * MiB;
constexpr size_t OFF_O = 1781 * MiB;
constexpr size_t OFF_MG = 1909 * MiB;
constexpr size_t OFF_HPRE = OFF_RT;
constexpr size_t OFF_Y = OFF_WGU;
constexpr size_t WS_NEED = 2037 * MiB;
static_assert(OFF_Y + (size_t)T * 9 * 2048 * 2 <= WS_NEED, "Y overlay");
constexpr int CW_CNT = 0, CW_TBASE = 128, CW_NT = 256, CW_CONV = 1024;

__device__ __forceinline__ unsigned f2bf(float f) { unsigned u = __float_as_uint(f); return (u + 0x7fffu + ((u >> 16) & 1u)) >> 16; }
__device__ __forceinline__ float bf2f(bf16_t b) { return __uint_as_float((unsigned)b << 16); }
__device__ __forceinline__ int crow(int i, int h) { return (i & 3) + 8 * (i >> 2) + 4 * h; }
__device__ __forceinline__ float wave_sum(float v) {
    v += __int_as_float(__builtin_amdgcn_update_dpp(0, __float_as_int(v), 0xB1, 0xF, 0xF, true));
    v += __int_as_float(__builtin_amdgcn_update_dpp(0, __float_as_int(v), 0x4E, 0xF, 0xF, true));
    v += __int_as_float(__builtin_amdgcn_update_dpp(0, __float_as_int(v), 0x141, 0xF, 0xF, true));
    v += __int_as_float(__builtin_amdgcn_update_dpp(0, __float_as_int(v), 0x140, 0xF, 0xF, true));
    const float r0 = __int_as_float(__builtin_amdgcn_readlane(__float_as_int(v), 0)), r1 = __int_as_float(__builtin_amdgcn_readlane(__float_as_int(v), 16));
    const float r2 = __int_as_float(__builtin_amdgcn_readlane(__float_as_int(v), 32)), r3 = __int_as_float(__builtin_amdgcn_readlane(__float_as_int(v), 48));
    return (r0 + r1) + (r2 + r3);
}
__device__ __forceinline__ float sigmoidf_(float x) { return 1.0f / (1.0f + __expf(-x)); }
#define LAS __attribute__((address_space(3)))
#define GAS __attribute__((address_space(1)))
typedef const GAS float* gfp;
typedef const GAS int* gip;
#define MFMA32(a, b, c) __builtin_amdgcn_mfma_f32_32x32x16_bf16((a), (b), (c), 0, 0, 0)

__device__ const int T5_BUCKET[128] = {0, 1, 2, 3, 4, 5, 6, 7, 8, 9, 10, 11, 12, 13, 14, 15, 16, 16, 16, 17, 17, 18, 18, 18, 19, 19, 19, 20, 20, 20, 20, 21, 21, 21, 21, 22, 22, 22, 22, 22, 23, 23, 23, 23, 23, 23, 24, 24, 24, 24, 24, 24, 25, 25, 25, 25, 25, 25, 25, 26, 26, 26, 26, 26, 26, 26, 26, 27, 27, 27, 27, 27, 27, 27, 27, 27, 27, 28, 28, 28, 28, 28, 28, 28, 28, 28, 28, 29, 29, 29, 29, 29, 29, 29, 29, 29, 29, 29, 29, 30, 30, 30, 30, 30, 30, 30, 30, 30, 30, 30, 30, 30, 30, 31, 31, 31, 31, 31, 31, 31, 31, 31, 31, 31, 31, 31, 31, 31};
__device__ const double ROPE_INV[32] = {1.0, 0.7498942093324559, 0.5623413251903491, 0.4216965034285822, 0.31622776601683794, 0.23713737056616552, 0.1778279410038923, 0.1333521432163324, 0.09999999999999999, 0.07498942093324558, 0.056234132519034905, 0.042169650342858224, 0.03162277660168379, 0.023713737056616554, 0.01778279410038923, 0.013335214321633239, 0.01, 0.007498942093324559, 0.005623413251903491, 0.004216965034285822, 0.0031622776601683794, 0.002371373705661655, 0.0017782794100389228, 0.0013335214321633238, 0.001, 0.0007498942093324559, 0.000562341325190349, 0.00042169650342858224, 0.00031622776601683794, 0.00023713737056616554, 0.0001778279410038923, 0.0001333521432163324};

struct MapId { __device__ int src(int n) const { return n; } __device__ float cs(int) const { return 1.f; } };
struct MapWin {
    __device__ int src(int n) const {
        if (n < 768) return n;
        if (n < 2304) return n + 64;
        if (n < 6400) { const int j = (n - 2304) >> 8, c = (n - 2304) & 255; return c < 128 ? 2368 + 128 * j + c : 2368 + 2048 + 128 * j + (c - 128); }
        const int c = n - 6400; if (c < 32) return 768 + c; if (c >= 128 && c < 160) return 800 + (c - 128); return -1;
    }
    __device__ float cs(int n) const { return (n >= 768 && n < 1792) ? SWA_QSCALE : 1.f; }
};
struct MapWinA {
    __device__ int src(int n) const { if (n < 768) return n; if (n < 2304) return n + 64; const int c = n - 2304; if (c < 32) return 768 + c; if (c >= 128 && c < 160) return 800 + (c - 128); return -1; }
    __device__ float cs(int n) const { return (n >= 768 && n < 1792) ? SWA_QSCALE : 1.f; }
};
struct MapWinG { __device__ int src(int n) const { const int j = n >> 8, c = n & 255; return c < 128 ? 2368 + 128 * j + c : 2368 + 2048 + 128 * j + (c - 128); } __device__ float cs(int) const { return 1.f; } };
struct MapWuq {
    __device__ int src(int n) const {
        if (n < 1024) return (n >> 7) * QKD + (n & 127);
        const int t = (n - 1024) >> 8, c = (n - 1024) & 255, half = c >> 7, hh = (c & 127) >> 5, i = c & 31;
        return (4 * t + hh) * QKD + NOPE + 32 * half + i;
    }
    __device__ float cs(int) const { return MLA_QSCALE; }
};
struct MapGU { __device__ int src(int n) const { const int p = n >> 8, c = n & 255; return c < 128 ? 128 * p + c : 512 + 128 * p + (c - 128); } __device__ float cs(int) const { return 1.f; } };

__device__ __forceinline__ unsigned pack4_fp8_(const f32x4& a) { int p = __float_as_int(a[0]); p = __builtin_amdgcn_cvt_pk_fp8_f32(a[0], a[1], p, false); p = __builtin_amdgcn_cvt_pk_fp8_f32(a[2], a[3], p, true); return (unsigned)p; }
template <class Map>
__device__ __forceinline__ void transpose_item(gfp W, int K, int Nsrc, bf16_t* __restrict__ WT, int Nout, int ldo, int koff, gfp kscale, LAS unsigned char* scr, int item, int lane) {
    const Map map{};
    const int nblk = Nout / 64, kb = item / nblk, nb = item % nblk, k0 = 64 * kb, n0 = 64 * nb;
    const int n4 = lane & 15, kr = lane >> 4, nl = 4 * n4;
    const int sc = map.src(n0 + nl); const float cs = map.cs(n0 + nl);
    f32x4 v[16];
    if (sc >= 0) {
        gfp wp = W + (size_t)(k0 + kr) * Nsrc + sc;
#pragma unroll
        for (int i = 0; i < 16; ++i) v[i] = *(const GAS f32x4*)(wp + (size_t)(4 * i) * Nsrc);
        if (kscale) {
#pragma unroll
            for (int i = 0; i < 16; ++i) v[i] = v[i] * (kscale[k0 + 4 * i + kr] * cs);
        } else if (cs != 1.f) {
#pragma unroll
            for (int i = 0; i < 16; ++i) v[i] = v[i] * cs;
        }
    } else {
#pragma unroll
        for (int i = 0; i < 16; ++i) v[i] = (f32x4){0.f, 0.f, 0.f, 0.f};
    }
#pragma unroll
    for (int i = 0; i < 16; ++i) { const int k = 4 * i + kr; const int cho = (((k >> 3) ^ (n4 & 7)) << 4) + ((k & 7) << 1);
#pragma unroll
        for (int e = 0; e < 4; ++e) *(LAS bf16_t*)(scr + (nl + e) * 128 + cho) = (bf16_t)f2bf(v[i][e]); }
    asm volatile("s_waitcnt lgkmcnt(0)" ::: "memory");
    const int c = lane & 7, nn0 = lane >> 3;
#pragma unroll
    for (int j = 0; j < 8; ++j) { const int nn = 8 * j + nn0; const u32x4 o = *(const LAS u32x4*)(scr + nn * 128 + ((c ^ ((nn >> 2) & 7)) << 4));
        *(u32x4*)(WT + (size_t)(n0 + nn) * ldo + koff + k0 + 8 * c) = o; }
    asm volatile("s_waitcnt lgkmcnt(0)" ::: "memory");
}
template <class Map>
__device__ __forceinline__ void transpose_item8(gfp W, int K, int Nsrc, unsigned char* __restrict__ WT, int Nout, int ldo, int koff, float scale, LAS unsigned char* scr, int item, int lane) {
    const Map map{};
    const int nblk = Nout / 64, kb = item / nblk, nb = item % nblk, k0 = 64 * kb, n0 = 64 * nb;
    const int n4 = lane & 15, kr = lane >> 4, nl = 4 * n4;
    const int sc = map.src(n0 + nl);
    f32x4 v[16];
    if (sc >= 0) { gfp wp = W + (size_t)(k0 + kr) * Nsrc + sc;
#pragma unroll
      for (int i = 0; i < 16; ++i) v[i] = *(const GAS f32x4*)(wp + (size_t)(4 * i) * Nsrc); }
    else {
#pragma unroll
      for (int i = 0; i < 16; ++i) v[i] = (f32x4){0.f, 0.f, 0.f, 0.f}; }
#pragma unroll
    for (int i = 0; i < 16; ++i) { const int k = 4 * i + kr; const int cho = (((k >> 4) ^ (n4 & 3)) << 4) + (k & 15);
        const unsigned p = pack4_fp8_(v[i] * (scale * map.cs(n0 + nl)));
#pragma unroll
        for (int e = 0; e < 4; ++e) *(LAS unsigned char*)(scr + (nl + e) * 64 + cho) = (unsigned char)(p >> (8 * e)); }
    asm volatile("s_waitcnt lgkmcnt(0)" ::: "memory");
    const int c = lane & 3, nn0 = lane >> 2;
#pragma unroll
    for (int j = 0; j < 4; ++j) { const int nn = 16 * j + nn0; const u32x4 o = *(const LAS u32x4*)(scr + nn * 64 + ((c ^ ((nn >> 2) & 3)) << 4));
        *(u32x4*)(WT + (size_t)(n0 + nn) * ldo + koff + k0 + 16 * c) = o; }
    asm volatile("s_waitcnt lgkmcnt(0)" ::: "memory");
}
template <class Map>
__device__ __forceinline__ void t8_load(gfp W, int Nsrc, int Nout, int item, int lane, f32x4 (&v)[16]) {
    const Map map{};
    const int nblk = Nout / 64, kb = item / nblk, nb = item % nblk, k0 = 64 * kb, n0 = 64 * nb;
    gfp wp = W + (size_t)(k0 + 16 * (lane >> 4)) * Nsrc + map.src(n0 + 4 * (lane & 15));
#pragma unroll
    for (int i = 0; i < 16; ++i) v[i] = __builtin_nontemporal_load((const GAS f32x4*)(wp + (size_t)i * Nsrc));
}
__device__ __forceinline__ void t8_proc(const f32x4 (&v)[16], unsigned char* __restrict__ WT, int Nout, int ldo, float scale, LAS unsigned char* scr, int item, int lane) {
    const int nblk = Nout / 64, kb = item / nblk, nb = item % nblk, k0 = 64 * kb, n0 = 64 * nb;
    const int n4 = lane & 15, kr = lane >> 4, nl = 4 * n4;
#pragma unroll
    for (int e = 0; e < 4; ++e) { u32x4 pk;
#pragma unroll
        for (int q = 0; q < 4; ++q) { int p = __float_as_int(v[4 * q][e]); p = __builtin_amdgcn_cvt_pk_fp8_f32(v[4 * q][e] * scale, v[4 * q + 1][e] * scale, p, false); p = __builtin_amdgcn_cvt_pk_fp8_f32(v[4 * q + 2][e] * scale, v[4 * q + 3][e] * scale, p, true); pk[q] = (unsigned)p; }
        *(LAS u32x4*)(scr + (nl + e) * 64 + ((kr ^ (n4 & 3)) << 4)) = pk; }
    asm volatile("s_waitcnt lgkmcnt(0)" ::: "memory");
    const int c = lane & 3, nn0 = lane >> 2;
#pragma unroll
    for (int j = 0; j < 4; ++j) { const int nn = 16 * j + nn0; const u32x4 o = *(const LAS u32x4*)(scr + nn * 64 + ((c ^ ((nn >> 2) & 3)) << 4));
        __builtin_nontemporal_store(o, (u32x4*)(WT + (size_t)(n0 + nn) * ldo + k0 + 16 * c)); }
    asm volatile("s_waitcnt lgkmcnt(0)" ::: "memory");
}
__device__ __forceinline__ int conv_claim(unsigned* ctr, int lane) { int v = 0; if (lane == 0) v = (int)__hip_atomic_fetch_add(ctr, 1u, __ATOMIC_RELAXED, __HIP_MEMORY_SCOPE_AGENT); return v; }
template <class Map>
__device__ __forceinline__ void conv_dynamic(gfp W, gfp Wsh, const int K, const int N, unsigned char* __restrict__ WT, unsigned* ctr, LAS unsigned char* scr, const int lane) {
    const int per = (K / 64) * (N / 64), n = per * (NE + 1); const size_t st = (size_t)K * N;
    f32x4 va[16], vb[16];
    int cur = __builtin_amdgcn_readfirstlane(conv_claim(ctr, lane)), nxt = __builtin_amdgcn_readfirstlane(conv_claim(ctr, lane));
#define CONV_SRC(it_) ((it_) / per < NE ? W + (size_t)((it_) / per) * st : Wsh)
    if (cur < n) t8_load<Map>(CONV_SRC(cur), N, N, cur % per, lane, va);
    while (cur < n) {
        int t = conv_claim(ctr, lane);
        if (nxt < n) t8_load<Map>(CONV_SRC(nxt), N, N, nxt % per, lane, vb);
        t8_proc(va, WT + (size_t)(cur / per) * st, N, K, W8_SCALE, scr, cur % per, lane);
        asm volatile("" : "+v"(t) :: "memory");
        cur = nxt; nxt = __builtin_amdgcn_readfirstlane(t);
        if (cur >= n) break;
        t = conv_claim(ctr, lane);
        if (nxt < n) t8_load<Map>(CONV_SRC(nxt), N, N, nxt % per, lane, va);
        t8_proc(vb, WT + (size_t)(cur / per) * st, N, K, W8_SCALE, scr, cur % per, lane);
        asm volatile("" : "+v"(t) :: "memory");
        cur = nxt; nxt = __builtin_amdgcn_readfirstlane(t);
    }
#undef CONV_SRC
}
template <class Map>
__device__ __forceinline__ void conv_static3(gfp W, const size_t wstride, const int Nsrc, unsigned char* __restrict__ WT, const size_t ostride, const int Nout, const int K, const int Z,
                                             const int gw, const int NGW, LAS unsigned char* scr, const int lane) {
    const int per = (K / 64) * (Nout / 64), n = per * Z; f32x4 va[16], vb[16], vc[16];
#define C3_LD(buf, idx) do { const int i_ = (idx) < n ? (idx) : n - 1; t8_load<Map>(W + (size_t)(i_ / per) * wstride, Nsrc, Nout, i_ % per, lane, buf); } while (0)
#define C3_PR(buf, idx) t8_proc(buf, WT + (size_t)((idx) / per) * ostride, Nout, K, W8_SCALE, scr, (idx) % per, lane)
    int it = gw; if (it >= n) return;
    C3_LD(va, it); C3_LD(vb, it + NGW);
    for (;;) {
        C3_LD(vc, it + 2 * NGW); C3_PR(va, it); if (it + NGW >= n) break;
        C3_LD(va, it + 3 * NGW); C3_PR(vb, it + NGW); if (it + 2 * NGW >= n) break;
        C3_LD(vb, it + 4 * NGW); C3_PR(vc, it + 2 * NGW); it += 3 * NGW; if (it >= n) break;
    }
#undef C3_LD
#undef C3_PR
}
__device__ __forceinline__ void b_router_split(const int vbid, const int vtid, gfp w, bf16_t* __restrict__ hi, bf16_t* __restrict__ lo) {
    const int idx = vbid * 256 + vtid; if (idx >= NE * DM) return;
    const int j = idx & 7, lane = (idx >> 3) & 63, nb = (idx >> 9) & 3, ks = (idx >> 11) & 7, wv = idx >> 14;
    const int e = 16 * nb + (lane & 15), k = 256 * wv + 32 * ks + 8 * (lane >> 4) + j;
    const float v = w[(size_t)k * NE + e]; const unsigned h = f2bf(v); const float r = v - __uint_as_float(h << 16);
    hi[idx] = (bf16_t)h; lo[idx] = (bf16_t)f2bf(r);
}
__device__ __forceinline__ void b_rope_table(const int vbid, const int vtid, gip pos, float* __restrict__ rc, float* __restrict__ rs) {
    const int idx = vbid * 256 + vtid; if (idx >= T * 32) return;
    const int t = idx >> 5, i = idx & 31;
    const double a = (double)pos[t] * ROPE_INV[i];
    const double k = __builtin_rint(a * 0.15915494309189535);
    const double r = __builtin_fma(-k, 6.283185307179586, a) - k * 2.4492935982947064e-16;
    const float rf = (float)r;
    rc[idx] = __cosf(rf); rs[idx] = __sinf(rf);
}

namespace pg8 {
constexpr int BM = 256, BK = 64, HALF = 128, HTB = HALF * BK * 2, STAGE_BYTES = 8 * HTB, NXCD = 8, WGM = 8;
__device__ __forceinline__ int lds_byte(int r, int c) { const int st = (r >> 4) * 2 + (c >> 5), rr = r & 15, cc = c & 31, ob = rr * 64 + cc * 2; return st * 1024 + (ob ^ (((ob >> 9) & 1) << 5)); }
__device__ __forceinline__ void stage_rc(int b, int& R, int& C) { const int st = b / 1024, sb = b % 1024, swz = sb ^ (((sb >> 9) & 1) << 5); R = (st >> 1) * 16 + swz / 64; C = (st & 1) * 32 + (swz % 64) / 2; }
__device__ __forceinline__ int perm32(int rho) { const int n = rho >> 4, i = rho & 15; return 8 * (i >> 2) + 4 * n + (i & 3); }
struct Unit { int pm, pn; size_t boff; };
struct MoeMap { const int* list; const LAS int* tbase; const LAS int* cnt; const LAS unsigned char* tile_e; };
__device__ __forceinline__ int moe_token(const MoeMap& mm, int pm, int r) { const int e = mm.tile_e[pm], idx = (pm - mm.tbase[e]) * 256 + r; if (e == NE) return idx; return idx < mm.cnt[e] ? mm.list[(size_t)e * T + idx] : 0; }
__device__ __forceinline__ int moe_dest(const MoeMap& mm, int pm, int r) { const int e = mm.tile_e[pm], idx = (pm - mm.tbase[e]) * 256 + r; if (e == NE) return idx * 9 + 8; return idx < mm.cnt[e] ? mm.list[(size_t)e * T + idx] : -1; }
struct Gemm { const void* A; const void* Bt; MoeMap mm; int K; int noepi; unsigned sa, sb; };
struct StaticOrder {
    int nM, nN, nwg, G, c, K;
    __device__ void init(int M, int N, int K_, int G_, int c_) { nM = M / BM; nN = N / BM; nwg = nM * nN; G = G_; c = c_; K = K_; }
    __device__ bool next(int i, Unit& u) const {
        const long L = (long)i * G + c; if (L >= nwg) return false;
        int wgid = (int)L; { const int q = nwg / NXCD, r = nwg % NXCD, xcd = wgid % NXCD, off = wgid / NXCD; wgid = (xcd < r ? xcd * (q + 1) : r * (q + 1) + (xcd - r) * q) + off; }
        const int nig = WGM * nN, gid = wgid / nig, fm = gid * WGM, gsz = (nM - fm) < WGM ? (nM - fm) : WGM;
        u.pm = __builtin_amdgcn_readfirstlane(fm + ((wgid % nig) % gsz)); u.pn = __builtin_amdgcn_readfirstlane((wgid % nig) / gsz); u.boff = (size_t)u.pn * BM * K; return true;
    }
};
struct MoeOrder {
    int NT, nN, G, c, K; size_t estride; const LAS unsigned char* tile_e;
    __device__ bool next(int i, Unit& u) const {
        const int x = c & 7, j = c >> 3, per = G >> 3, s = i * per + j, gsz = 8 * nN;
        const int grp = (s / gsz) * 8 + x, idx = s % gsz, pm = grp * 8 + (idx & 7), pn = idx >> 3;
        if (grp * 8 >= NT) return false;
        const int pmc = __builtin_amdgcn_readfirstlane(pm < NT ? pm : NT - 1); u.pn = __builtin_amdgcn_readfirstlane(pn); const int e = __builtin_amdgcn_readfirstlane((int)tile_e[pmc]); u.boff = (size_t)e * estride + (size_t)u.pn * BM * K;
        u.pm = __builtin_amdgcn_readfirstlane(pm >= NT ? -1 - pmc : pmc);
        return true;
    }
};
__device__ __forceinline__ unsigned cvt_pk_bf16(float lo, float hi) { unsigned r; asm volatile("v_cvt_pk_bf16_f32 %0, %1, %2" : "=v"(r) : "v"(lo), "v"(hi)); return r; }
__device__ __forceinline__ u32x4 pack8(const f32x4& a, const f32x4& b) { u32x4 w; w.x = cvt_pk_bf16(a[0], a[1]); w.y = cvt_pk_bf16(a[2], a[3]); w.z = cvt_pk_bf16(b[0], b[1]); w.w = cvt_pk_bf16(b[2], b[3]); return w; }
__device__ __forceinline__ void unpack8(const u32x4& w, f32x4& a, f32x4& b) {
    a[0] = __uint_as_float(w.x << 16); a[1] = __uint_as_float(w.x & 0xffff0000u); a[2] = __uint_as_float(w.y << 16); a[3] = __uint_as_float(w.y & 0xffff0000u);
    b[0] = __uint_as_float(w.z << 16); b[1] = __uint_as_float(w.z & 0xffff0000u); b[2] = __uint_as_float(w.w << 16); b[3] = __uint_as_float(w.w & 0xffff0000u); }

__device__ __forceinline__ const char* uptr(const char* p) { const unsigned long long v = (unsigned long long)p; const unsigned lo = __builtin_amdgcn_readfirstlane((unsigned)v), hi = __builtin_amdgcn_readfirstlane((unsigned)(v >> 32)); return (const char*)(((unsigned long long)hi << 32) | lo); }
template <bool GATHER, int ES, class Epi, class Sched>
__device__ __forceinline__ void gemm_phase(LAS unsigned char* lds, const Gemm g, const Sched& S, const Epi& E) {
    int tid = threadIdx.x; asm volatile("" : "+v"(tid));
    const int wid = __builtin_amdgcn_readfirstlane(tid >> 6), lane = tid & 63, wr = wid >> 2, wc = wid & 3, fr = lane & 15, fq = lane >> 4;
    int Kop = g.K; asm volatile("" : "+s"(Kop));
    const int K = Kop * ES;
    const int nt = K / 128;
    int RA[2]; unsigned voffA[2], voffB[2];
#pragma unroll
    for (int i = 0; i < 2; ++i) { int R, C; stage_rc(tid * 16 + i * 8192, R, C); const int Rb = (R & ~31) + perm32(R & 31); RA[i] = R; voffA[i] = GATHER ? (unsigned)C * 2u : (unsigned)(R * K) + (unsigned)C * 2u;
        const int Rb64 = 64 * (R >> 5) + 16 * ((R & 15) >> 2) + 4 * ((R >> 4) & 1) + (R & 3);
        voffB[i] = (unsigned)((Epi::BMAP ? Rb64 : Rb) * K) + (unsigned)C * 2u; }
    const size_t kstep = (size_t)(BK * 2);
    const size_t hstep = (size_t)HALF * K;
    const size_t tstep = 2 * hstep;
    const size_t hstepB = Epi::BMAP ? (size_t)8 * K : hstep;
    const unsigned ldsw = (unsigned)wid * 1024u;
    const int aoff = lds_byte(wr * 64 + fr, fq * 8), boff = lds_byte(wc * 32 + fr, fq * 8);
#define PG8_SA(b, h) (((b) * 2 + (h)) * HTB)
#define PG8_SB(b, h) ((4 + (b) * 2 + (h)) * HTB)
#define PG8_STAGEB(bufoff, gbase) do { _Pragma("unroll") for (int _i = 0; _i < 2; ++_i) \
        __builtin_amdgcn_global_load_lds((const unsigned*)((const char*)(gbase) + voffB[_i]), (LAS unsigned*)(lds + (bufoff) + ldsw + _i * 8192), 16, 0, 0); } while (0)
#define PG8_STAGEA(bufoff, gbase, v0, v1) do { \
        __builtin_amdgcn_global_load_lds((const unsigned*)((const char*)(gbase) + (v0)), (LAS unsigned*)(lds + (bufoff) + ldsw), 16, 0, 0); \
        __builtin_amdgcn_global_load_lds((const unsigned*)((const char*)(gbase) + (v1)), (LAS unsigned*)(lds + (bufoff) + ldsw + 8192), 16, 0, 0); } while (0)
    typedef int v8i_ __attribute__((ext_vector_type(8)));
#define PG8_LDA(dst, b, h) do { if constexpr (ES == 2) { _Pragma("unroll") for (int m = 0; m < 4; ++m) _Pragma("unroll") for (int k = 0; k < 2; ++k) dst[m][k] = *(const LAS bf16x8*)(lds + PG8_SA(b, h) + aoff + m * 2048 + k * 1024); } \
        else { typedef int v4i_ __attribute__((ext_vector_type(4))); _Pragma("unroll") for (int m = 0; m < 4; ++m) { const v4i_ lo_ = *(const LAS v4i_*)(lds + PG8_SA(b, h) + aoff + m * 2048), hi_ = *(const LAS v4i_*)(lds + PG8_SA(b, h) + aoff + m * 2048 + 1024); \
            dst##8[m] = __builtin_shufflevector(lo_, hi_, 0, 1, 2, 3, 4, 5, 6, 7); } } } while (0)
#define PG8_LDB(dst, b, h) do { if constexpr (ES == 2) { _Pragma("unroll") for (int n = 0; n < 2; ++n) _Pragma("unroll") for (int k = 0; k < 2; ++k) dst[n][k] = *(const LAS bf16x8*)(lds + PG8_SB(b, h) + boff + n * 2048 + k * 1024); } \
        else { typedef int v4i_ __attribute__((ext_vector_type(4))); _Pragma("unroll") for (int n = 0; n < 2; ++n) { const v4i_ lo_ = *(const LAS v4i_*)(lds + PG8_SB(b, h) + boff + n * 2048), hi_ = *(const LAS v4i_*)(lds + PG8_SB(b, h) + boff + n * 2048 + 1024); \
            dst##8[n] = __builtin_shufflevector(lo_, hi_, 0, 1, 2, 3, 4, 5, 6, 7); } } } while (0)
#ifdef GEMM_PROBES
#define PG8_NOMMA (g.noepi & 4)
#else
#define PG8_NOMMA false
#endif
#define PG8_MMA(ai, bj, At, Bt) do { if (PG8_NOMMA) break; __builtin_amdgcn_s_setprio(1); _Pragma("unroll") for (int m = 0; m < 4; ++m) _Pragma("unroll") for (int n = 0; n < 2; ++n) { \
        if constexpr (ES == 2) { _Pragma("unroll") for (int k = 0; k < 2; ++k) acc[ai][bj][m][n] = __builtin_amdgcn_mfma_f32_16x16x32_bf16(Bt[n][k], At[m][k], acc[ai][bj][m][n], 0, 0, 0); } \
        else asm volatile("v_mfma_scale_f32_16x16x128_f8f6f4 %0, %1, %2, %0, %3, %4 op_sel_hi:[0,0,0]" : "+v"(acc[ai][bj][m][n]) : "v"(Bt##8[n]), "v"(At##8[m]), "v"(vsb), "v"(vsa)); } \
        __builtin_amdgcn_s_setprio(0); } while (0)
#define PG8_WAIT_V(n) asm volatile("s_waitcnt vmcnt(" #n ")" ::: "memory")
#define PG8_WAIT_L(n) asm volatile("s_waitcnt lgkmcnt(" #n ")" ::: "memory")
#define PG8_BAR __builtin_amdgcn_s_barrier()
#define PG8_SCHED __builtin_amdgcn_sched_barrier(0)
#define PG8_AOFF_RAW(raw, mk, sb, u_) do { if (GATHER) { const int pm_ = (u_).pm < 0 ? -1 - (u_).pm : (u_).pm; const int e_ = __builtin_amdgcn_readfirstlane((int)g.mm.tile_e[pm_]); \
        const int base_ = (pm_ - __builtin_amdgcn_readfirstlane(g.mm.tbase[e_])) * 256; const int es_ = e_ == NE ? 0 : e_, c_ = e_ == NE ? 0 : __builtin_amdgcn_readfirstlane(g.mm.cnt[es_]); \
        const int* lp_ = g.mm.list + (size_t)es_ * T; int m_ = 0; \
        _Pragma("unroll") for (int h_ = 0; h_ < 2; ++h_) _Pragma("unroll") for (int i_ = 0; i_ < 2; ++i_) { const int idx_ = base_ + h_ * HALF + RA[i_]; raw[h_][i_] = (unsigned)lp_[idx_ < c_ ? idx_ : 0]; m_ |= (idx_ < c_ ? 1 : 0) << (2 * h_ + i_); } \
        mk = e_ == NE ? -1 : m_; sb = base_; } } while (0)
#define PG8_AOFF_FIN(dst, raw, mk, sb) do { if (GATHER) { _Pragma("unroll") for (int h_ = 0; h_ < 2; ++h_) _Pragma("unroll") for (int i_ = 0; i_ < 2; ++i_) \
        dst[h_][i_] = ((mk) < 0 ? (unsigned)((sb) + h_ * HALF + RA[i_]) : ((((mk) >> (2 * h_ + i_)) & 1) ? raw[h_][i_] : 0u)) * (unsigned)K + voffA[i_]; } } while (0)
#define PG8_AOFF(dst, u_) do { unsigned raw_[2][2] = {{0u, 0u}, {0u, 0u}}; int mk_ = 0, sb_ = 0; PG8_AOFF_RAW(raw_, mk_, sb_, u_); PG8_AOFF_FIN(dst, raw_, mk_, sb_); } while (0)
#define PG8_PMROW(u_) ((size_t)((u_).pm < 0 ? -1 - (u_).pm : (u_).pm))
    Unit cur, nxt; int ui = 0;
    if (!S.next(0, cur)) return;
#ifdef GEMM_PROBES
    if (g.noepi & 2) { cur.pm = 0; cur.pn = 0; cur.boff = 0; }
#endif
    f32x4 acc[2][2][4][2];
#pragma unroll
    for (int a = 0; a < 2; ++a)
#pragma unroll
        for (int b = 0; b < 2; ++b)
#pragma unroll
            for (int m = 0; m < 4; ++m)
#pragma unroll
                for (int n = 0; n < 2; ++n) acc[a][b][m][n] = (f32x4){0.f, 0.f, 0.f, 0.f};
    bf16x8 At[4][2], B0[2][2], B1[2][2];
    v8i_ At8[4], B08[2], B18[2];
    const unsigned vsa = g.sa, vsb = g.sb; (void)vsa; (void)vsb;
    unsigned vc[2][2], vn[2][2], vnn[2][2] = {{0u, 0u}, {0u, 0u}};
    PG8_AOFF(vc, cur);
    if (GATHER) { Unit n1_; if (S.next(1, n1_)) { PG8_AOFF(vn, n1_); } else { _Pragma("unroll") for (int h_ = 0; h_ < 2; ++h_) _Pragma("unroll") for (int i_ = 0; i_ < 2; ++i_) vn[h_][i_] = vc[h_][i_]; } }
    if constexpr (Epi::PRE) { E.pre(cur, wr, fr); E.rot(); }
    const char* cA = uptr(GATHER ? (const char*)g.A : (const char*)g.A + PG8_PMROW(cur) * tstep);
    const char* cB = uptr((const char*)g.Bt + cur.boff * ES);
#define VA(X, h, i) (GATHER ? X[h][i] : voffA[i])
#define HS(h) (GATHER ? (size_t)0 : (size_t)(h) * hstep)
    PG8_STAGEB(PG8_SB(0, 0), cB); PG8_STAGEB(PG8_SB(0, 1), cB + hstepB); PG8_STAGEA(PG8_SA(0, 0), cA, VA(vc, 0, 0), VA(vc, 0, 1)); PG8_STAGEA(PG8_SA(0, 1), cA + HS(1), VA(vc, 1, 0), VA(vc, 1, 1));
    if (wr == 1) PG8_BAR;
    PG8_WAIT_V(2); PG8_BAR;
    PG8_STAGEB(PG8_SB(1, 0), cB + kstep); PG8_STAGEA(PG8_SA(1, 0), cA + kstep, VA(vc, 0, 0), VA(vc, 0, 1)); PG8_STAGEB(PG8_SB(1, 1), cB + hstepB + kstep);
    PG8_WAIT_V(6); PG8_BAR;
    for (;;) {
        const bool has_next = S.next(ui + 1, nxt);
#ifdef GEMM_PROBES
        if (g.noepi & 2) { nxt.pm = 0; nxt.pn = 0; nxt.boff = 0; }
#endif
        const char* nA = uptr(GATHER ? cA : (has_next ? (const char*)g.A + PG8_PMROW(nxt) * tstep : cA));
        const char* nB = uptr(has_next ? (const char*)g.Bt + nxt.boff * ES : cB);
        for (int part = 0; part < (Epi::MID ? 2 : 1); ++part) {
        if (Epi::MID && part == 1) { if constexpr (ES == 1) asm volatile("s_nop 15\n\ts_nop 15" ::: "memory"); E.mid(acc, cur, wr, wc, fr, fq); if constexpr (ES == 1) asm volatile("s_nop 7" ::: "memory"); }
        const int t_lo = Epi::MID ? part * (nt >> 1) : 0, t_hi = Epi::MID ? (part + 1) * (nt >> 1) : nt;
        for (int t = t_lo; t < t_hi; t += 2) {
            const bool last = (t == nt - 2);
            const char* a1 = cA + (size_t)(t + 1) * kstep;
            const char* a2 = last ? nA : cA + (size_t)(t + 2) * kstep; const char* b2 = last ? nB : cB + (size_t)(t + 2) * kstep;
            const char* a3 = a2 + kstep; const char* b3 = b2 + kstep;
            unsigned w00 = 0, w01 = 0, w10 = 0, w11 = 0;
            if (GATHER) { w00 = last ? vn[0][0] : vc[0][0]; w01 = last ? vn[0][1] : vc[0][1]; w10 = last ? vn[1][0] : vc[1][0]; w11 = last ? vn[1][1] : vc[1][1]; }
#define WA(h, i, w) (GATHER ? (w) : voffA[i])
            PG8_LDB(B0, 0, 0); PG8_LDB(B1, 0, 1); PG8_SCHED; PG8_LDA(At, 0, 0); PG8_STAGEA(PG8_SA(1, 1), a1 + HS(1), VA(vc, 1, 0), VA(vc, 1, 1));
            PG8_WAIT_V(8); PG8_WAIT_L(0); PG8_BAR; PG8_MMA(0, 0, At, B0); PG8_MMA(0, 1, At, B1); PG8_BAR; PG8_SCHED;
            PG8_LDA(At, 0, 1); PG8_STAGEB(PG8_SB(0, 0), b2); PG8_STAGEB(PG8_SB(0, 1), b2 + hstepB); PG8_STAGEA(PG8_SA(0, 0), a2, WA(0, 0, w00), WA(0, 1, w01));
            PG8_WAIT_V(8); PG8_WAIT_L(0); PG8_BAR; PG8_MMA(1, 0, At, B0); PG8_MMA(1, 1, At, B1); PG8_BAR; PG8_SCHED;
            PG8_LDB(B0, 1, 0); PG8_LDB(B1, 1, 1); PG8_SCHED; PG8_LDA(At, 1, 0); PG8_STAGEA(PG8_SA(0, 1), a2 + HS(1), WA(1, 0, w10), WA(1, 1, w11));
            PG8_WAIT_V(8); PG8_WAIT_L(0); PG8_BAR; PG8_MMA(0, 0, At, B0); PG8_MMA(0, 1, At, B1); PG8_BAR; PG8_SCHED;
            PG8_LDA(At, 1, 1); PG8_STAGEB(PG8_SB(1, 0), b3); PG8_STAGEB(PG8_SB(1, 1), b3 + hstepB); PG8_STAGEA(PG8_SA(1, 0), a3, WA(0, 0, w00), WA(0, 1, w01));
            PG8_WAIT_V(8); PG8_WAIT_L(0); PG8_BAR; PG8_MMA(1, 0, At, B0); PG8_MMA(1, 1, At, B1); PG8_BAR; PG8_SCHED;
#undef WA
        }
        }
        int mkn_ = 0, sbn_ = 0; bool hnn_ = false; if (GATHER) { Unit nn_; hnn_ = S.next(ui + 2, nn_); if (hnn_) { PG8_AOFF_RAW(vnn, mkn_, sbn_, nn_); } }
        if constexpr (Epi::PRE) { if (has_next) E.pre(nxt, wr, fr); }
        if (Epi::ALIGN) { if (wr == 0) PG8_BAR; }
        if constexpr (ES == 1) asm volatile("s_nop 15\n\ts_nop 15" ::: "memory");
        if (cur.pm >= 0 && !(g.noepi & 1)) E(acc, cur, wr, wc, fr, fq);
        if (!has_next) break;
#pragma unroll
        for (int a = 0; a < 2; ++a)
#pragma unroll
            for (int b = 0; b < 2; ++b)
#pragma unroll
                for (int m = 0; m < 4; ++m)
#pragma unroll
                    for (int n = 0; n < 2; ++n) acc[a][b][m][n] = (f32x4){0.f, 0.f, 0.f, 0.f};
        cur = nxt; cA = nA; cB = nB; ++ui;
        if (GATHER) {
#pragma unroll
            for (int h_ = 0; h_ < 2; ++h_)
#pragma unroll
                for (int i_ = 0; i_ < 2; ++i_) vc[h_][i_] = vn[h_][i_];
            if (hnn_) { PG8_AOFF_FIN(vn, vnn, mkn_, sbn_); } }
        if constexpr (Epi::PRE) E.rot();
        if (Epi::ALIGN) { if (wr == 1) PG8_BAR; }
    }
    PG8_WAIT_V(0);
    if (!Epi::ALIGN) { if (wr == 0) PG8_BAR; }
    PG8_BAR;
#undef VA
#undef HS
#undef PG8_PMROW
#undef PG8_SA
#undef PG8_SB
#undef PG8_STAGEA
#undef PG8_STAGEB
#undef PG8_LDA
#undef PG8_LDB
#undef PG8_MMA
#undef PG8_WAIT_V
#undef PG8_WAIT_L
#undef PG8_BAR
#undef PG8_SCHED
#undef PG8_AOFF
}

__device__ __forceinline__ unsigned pack4_fp8(const f32x4& a) { int p = __float_as_int(a[0]); p = __builtin_amdgcn_cvt_pk_fp8_f32(a[0], a[1], p, false); p = __builtin_amdgcn_cvt_pk_fp8_f32(a[2], a[3], p, true); return (unsigned)p; }
#define EPI_ROWS1(...) _Pragma("unroll") for (int ai = 0; ai < 2; ++ai) _Pragma("unroll") for (int m = 0; m < 4; ++m) { const int row = rowb + ai * HALF + m * 16; __VA_ARGS__ asm volatile("" ::: "memory"); }
#define EPI_ROWS(...) _Pragma("unroll") for (int ai = 0; ai < 2; ++ai) _Pragma("unroll") for (int m = 0; m < 4; ++m) { const int row = rowb + ai * HALF + m * 16; __VA_ARGS__ if (m & 1) asm volatile("" ::: "memory"); }
struct FProj {
    static constexpr bool PRE = false; static constexpr bool MID = false; static constexpr int BMAP = 0; static constexpr bool ALIGN = true;
    bf16_t *CQ, *CKV, *QS, *KS, *VS, *KR, *RT, *G1; gfp bgate; const float *rc, *rs; float* ssq; int mode;
    __device__ __forceinline__ void mid(f32x4 (&)[2][2][4][2], const Unit&, int, int, int, int) const {}
    __device__ __forceinline__ void operator()(const f32x4 (&acc)[2][2][4][2], const Unit& u, int wr, int wc, int fr, int fq) const {
        const int pn = mode == 0 ? u.pn : (mode == 1 ? (u.pn < 9 ? u.pn : 25) : u.pn + 9), c8 = wc * 32 + 8 * fq, rowb = u.pm * BM + wr * 64 + fr;
        if (pn < 9) {
            bf16_t* base; int ld, colt;
            if (pn < 2) { base = CQ; ld = 512; colt = pn * 256; } else if (pn == 2) { base = CKV; ld = 256; colt = 0; } else if (pn < 7) { base = QS; ld = 1024; colt = (pn - 3) * 256; }
            else if (pn == 7) { base = KS; ld = 256; colt = 0; } else { base = VS; ld = 256; colt = 0; }
            EPI_ROWS(
                bf16_t* rp = base + (size_t)row * ld + colt + c8; float s = 0.f;
                _Pragma("unroll") for (int bj = 0; bj < 2; ++bj) { const f32x4 a = acc[ai][bj][m][0], b = acc[ai][bj][m][1]; *(u32x4*)(rp + bj * HALF) = pack8(a, b);
                    s += (a[0] * a[0] + a[1] * a[1]) + (a[2] * a[2] + a[3] * a[3]) + (b[0] * b[0] + b[1] * b[1]) + (b[2] * b[2] + b[3] * b[3]); }
                if (pn < 3) { s += __shfl_xor(s, 16); s += __shfl_xor(s, 32); if (fq == 0) ssq[(size_t)row * 12 + pn * 4 + wc] = s; }
            )
        } else if (pn < 25) {
            const int gcol = (pn - 9) * 128 + c8;
            const f32x4 b00 = *(const GAS f32x4*)(bgate + gcol) * -1.44269504f, b01 = *(const GAS f32x4*)(bgate + gcol + 4) * -1.44269504f, b10 = *(const GAS f32x4*)(bgate + DM + gcol) * -1.44269504f, b11 = *(const GAS f32x4*)(bgate + DM + gcol + 4) * -1.44269504f;
            EPI_ROWS(
                f32x4 rt[2], gg[2];
                _Pragma("unroll") for (int n = 0; n < 2; ++n) { const f32x4 nb0 = n ? b01 : b00, nb1 = n ? b11 : b10;
                    _Pragma("unroll") for (int j = 0; j < 4; ++j) { const float e0 = __builtin_amdgcn_exp2f(__builtin_fmaf(acc[ai][0][m][n][j], -1.44269504f, nb0[j])), e1 = __builtin_amdgcn_exp2f(fminf(__builtin_fmaf(acc[ai][1][m][n][j], -1.44269504f, nb1[j]), 40.f));
                        const float u0 = __builtin_fmaf(e0, 1.0f / G18_SCALE, 1.0f / G18_SCALE), u1 = __builtin_fmaf(e1, 1.0f / G18_SCALE, 1.0f / G18_SCALE);
                        gg[n][j] = __builtin_amdgcn_rcpf(u1); rt[n][j] = u1 * __builtin_amdgcn_rcpf(u0); } }
                if (GATE8) { u32x2 pr, pg; pr.x = pack4_fp8(rt[0]); pr.y = pack4_fp8(rt[1]); pg.x = pack4_fp8(gg[0]); pg.y = pack4_fp8(gg[1]);
                    *(u32x2*)((unsigned char*)RT + (size_t)row * DM + gcol) = pr; *(u32x2*)((unsigned char*)G1 + (size_t)row * DM + gcol) = pg; }
                else { *(u32x4*)(RT + (size_t)row * DM + gcol) = pack8(rt[0], rt[1]); *(u32x4*)(G1 + (size_t)row * DM + gcol) = pack8(gg[0] * (1.0f / G18_SCALE), gg[1] * (1.0f / G18_SCALE)); }
            )
        } else if (wc == 0) {
            EPI_ROWS(
                f32x4 o1[2], o2[2];
                _Pragma("unroll") for (int n = 0; n < 2; ++n) { const f32x4 cs = *(const f32x4*)(rc + (size_t)row * 32 + 8 * fq + 4 * n), sn = *(const f32x4*)(rs + (size_t)row * 32 + 8 * fq + 4 * n);
                    const f32x4 x1 = acc[ai][0][m][n], x2 = acc[ai][1][m][n]; o1[n] = x1 * cs - x2 * sn; o2[n] = x1 * sn + x2 * cs; }
                *(u32x4*)(KR + (size_t)row * 64 + 8 * fq) = pack8(o1[0], o1[1]); *(u32x4*)(KR + (size_t)row * 64 + 32 + 8 * fq) = pack8(o2[0], o2[1]);
            )
        }
    }
};
struct FQ {
    static constexpr bool PRE = false; static constexpr bool MID = false; static constexpr int BMAP = 0; static constexpr bool ALIGN = true;
    bf16_t* Q; const float* ssq; const float *rc, *rs;
    __device__ __forceinline__ void mid(f32x4 (&)[2][2][4][2], const Unit&, int, int, int, int) const {}
    __device__ __forceinline__ void operator()(const f32x4 (&acc)[2][2][4][2], const Unit& u, int wr, int wc, int fr, int fq) const {
        const int pn = u.pn, c8 = wc * 32 + 8 * fq, rowb = u.pm * BM + wr * 64 + fr;
#pragma unroll
        for (int ai = 0; ai < 2; ++ai) {
            float scl[4];
#pragma unroll
            for (int m = 0; m < 4; ++m) { const size_t row = (size_t)(rowb + ai * HALF + m * 16);
                const f32x4 s0 = *(const f32x4*)(ssq + row * 12), s1 = *(const f32x4*)(ssq + row * 12 + 4);
                scl[m] = 1.0f / sqrtf((((s0[0] + s0[1]) + (s0[2] + s0[3])) + ((s1[0] + s1[1]) + (s1[2] + s1[3]))) * (1.0f / QR) + RMS_EPS); }
            asm volatile("" ::: "memory");
#pragma unroll
            for (int m = 0; m < 4; ++m) { const int row = rowb + ai * HALF + m * 16; const float sc = scl[m];
                bf16_t* q = Q + (size_t)row * (MH * QKD);
                if (pn < 4) { _Pragma("unroll") for (int bj = 0; bj < 2; ++bj) *(u32x4*)(q + (2 * pn + bj) * QKD + c8) = pack8(acc[ai][bj][m][0] * sc, acc[ai][bj][m][1] * sc); }
                else { const int head = 4 * (pn - 4) + wc; f32x4 o1[2], o2[2];
                    _Pragma("unroll") for (int n = 0; n < 2; ++n) { const f32x4 cs = *(const f32x4*)(rc + (size_t)row * 32 + 8 * fq + 4 * n), sn = *(const f32x4*)(rs + (size_t)row * 32 + 8 * fq + 4 * n);
                        const f32x4 x1 = acc[ai][0][m][n] * sc, x2 = acc[ai][1][m][n] * sc; o1[n] = x1 * cs - x2 * sn; o2[n] = x1 * sn + x2 * cs; }
                    *(u32x4*)(q + head * QKD + NOPE + 8 * fq) = pack8(o1[0], o1[1]); *(u32x4*)(q + head * QKD + NOPE + 32 + 8 * fq) = pack8(o2[0], o2[1]); }
                if (m & 1) asm volatile("" ::: "memory"); }
        }
    }
};
struct FKV {
    static constexpr bool PRE = false; static constexpr bool MID = false; static constexpr int BMAP = 0; static constexpr bool ALIGN = true;
    bf16_t *KN, *VM; const float* ssq;
    __device__ __forceinline__ void mid(f32x4 (&)[2][2][4][2], const Unit&, int, int, int, int) const {}
    __device__ __forceinline__ void operator()(const f32x4 (&acc)[2][2][4][2], const Unit& u, int wr, int wc, int fr, int fq) const {
        const int pn = u.pn, c8 = wc * 32 + 8 * fq, rowb = u.pm * BM + wr * 64 + fr;
        bf16_t* base = (pn < 4 ? KN : VM) + (pn & 3) * 256 + c8;
        float scl[2][4];
        EPI_ROWS( const f32x4 s0 = *(const f32x4*)(ssq + (size_t)row * 12 + 8); scl[ai][m] = 1.0f / sqrtf(((s0[0] + s0[1]) + (s0[2] + s0[3])) * (1.0f / KVR) + RMS_EPS); )
        EPI_ROWS(
            const float sc = scl[ai][m];
            _Pragma("unroll") for (int bj = 0; bj < 2; ++bj) *(u32x4*)(base + (size_t)row * 1024 + bj * HALF) = pack8(acc[ai][bj][m][0] * sc, acc[ai][bj][m][1] * sc);
        )
    }
};
__device__ __forceinline__ void unpack8_fp8(const u32x2& w, f32x4& a, f32x4& b) { typedef float f32x2_ __attribute__((ext_vector_type(2)));
    const f32x2_ a0 = __builtin_amdgcn_cvt_pk_f32_fp8((int)w.x, false), a1 = __builtin_amdgcn_cvt_pk_f32_fp8((int)w.x, true), b0 = __builtin_amdgcn_cvt_pk_f32_fp8((int)w.y, false), b1 = __builtin_amdgcn_cvt_pk_f32_fp8((int)w.y, true);
    a = (f32x4){a0[0], a0[1], a1[0], a1[1]}; b = (f32x4){b0[0], b0[1], b1[0], b1[1]}; }
struct FMerge {
    static constexpr bool PRE = false; static constexpr bool MID = true; static constexpr int BMAP = 0; static constexpr bool ALIGN = true;
    const bf16_t *RT, *G1; bf16_t* MG;
    __device__ __forceinline__ void mid(f32x4 (&acc)[2][2][4][2], const Unit& u, int, int, int, int) const {
        int t_ = threadIdx.x; asm volatile("" : "+v"(t_)); const int wr = t_ >> 8, wc = (t_ >> 6) & 3, fr = t_ & 15, fq = (t_ >> 4) & 3;
        const int rowb = u.pm * BM + wr * 64 + fr, col = u.pn * BM + wc * 32 + 8 * fq;
        if (GATE8) {
            u32x2 w[2][4][2];
#pragma unroll
            for (int ai = 0; ai < 2; ++ai)
#pragma unroll
                for (int m = 0; m < 4; ++m)
#pragma unroll
                    for (int bj = 0; bj < 2; ++bj) w[ai][m][bj] = *(const u32x2*)((const unsigned char*)RT + (size_t)(rowb + ai * HALF + m * 16) * DM + col + bj * HALF);
#pragma unroll
            for (int ai = 0; ai < 2; ++ai)
#pragma unroll
                for (int m = 0; m < 4; ++m)
#pragma unroll
                    for (int bj = 0; bj < 2; ++bj) { f32x4 a, b; unpack8_fp8(w[ai][m][bj], a, b); acc[ai][bj][m][0] *= a; acc[ai][bj][m][1] *= b; }
        } else {
        u32x4 w[2][4][2];
#pragma unroll
        for (int ai = 0; ai < 2; ++ai)
#pragma unroll
            for (int m = 0; m < 4; ++m)
#pragma unroll
                for (int bj = 0; bj < 2; ++bj) w[ai][m][bj] = *(const u32x4*)(RT + (size_t)(rowb + ai * HALF + m * 16) * DM + col + bj * HALF);
#pragma unroll
        for (int ai = 0; ai < 2; ++ai)
#pragma unroll
            for (int m = 0; m < 4; ++m)
#pragma unroll
                for (int bj = 0; bj < 2; ++bj) { f32x4 a, b; unpack8(w[ai][m][bj], a, b); acc[ai][bj][m][0] *= a; acc[ai][bj][m][1] *= b; }
        }
    }
    __device__ __forceinline__ void operator()(const f32x4 (&acc)[2][2][4][2], const Unit& u, int, int, int, int) const {
        int t_ = threadIdx.x; asm volatile("" : "+v"(t_)); const int wr = t_ >> 8, wc = (t_ >> 6) & 3, fr = t_ & 15, fq = (t_ >> 4) & 3;
        const int rowb = u.pm * BM + wr * 64 + fr, col = u.pn * BM + wc * 32 + 8 * fq;
#pragma unroll
        for (int ai = 0; ai < 2; ++ai)
#pragma unroll
            for (int mp = 0; mp < 2; ++mp) {
                u32x4 wv[2][2]; u32x2 wv8[2][2];
#pragma unroll
                for (int m2 = 0; m2 < 2; ++m2)
#pragma unroll
                    for (int bj = 0; bj < 2; ++bj) { const size_t o = (size_t)(rowb + ai * HALF + (2 * mp + m2) * 16) * DM + col + bj * HALF;
                        if (GATE8) wv8[m2][bj] = *(const u32x2*)((const unsigned char*)G1 + o); else wv[m2][bj] = *(const u32x4*)(G1 + o); }
                asm volatile("" ::: "memory");
#pragma unroll
                for (int m2 = 0; m2 < 2; ++m2)
#pragma unroll
                    for (int bj = 0; bj < 2; ++bj) { const int m = 2 * mp + m2; f32x4 a, b; if (GATE8) { unpack8_fp8(wv8[m2][bj], a, b); if (!(MIX_FP8 && G18_SCALE == MG8_SCALE)) { a = a * (1.0f / G18_SCALE); b = b * (1.0f / G18_SCALE); } } else unpack8(wv[m2][bj], a, b);
                        if (MIX_FP8 && GATE8 && G18_SCALE == MG8_SCALE) { u32x2 pk; pk.x = pack4_fp8(acc[ai][bj][m][0] * a); pk.y = pack4_fp8(acc[ai][bj][m][1] * b);     *(u32x2*)((unsigned char*)MG + (size_t)(rowb + ai * HALF + m * 16) * DM + col + bj * HALF) = pk; }
                        else if (MIX_FP8) { u32x2 pk; pk.x = pack4_fp8(acc[ai][bj][m][0] * a * MG8_SCALE); pk.y = pack4_fp8(acc[ai][bj][m][1] * b * MG8_SCALE); *(u32x2*)((unsigned char*)MG + (size_t)(rowb + ai * HALF + m * 16) * DM + col + bj * HALF) = pk; }
                        else *(u32x4*)(MG + (size_t)(rowb + ai * HALF + m * 16) * DM + col + bj * HALF) = pack8(acc[ai][bj][m][0] * a, acc[ai][bj][m][1] * b); }
                asm volatile("" ::: "memory");
            }
    }
};
struct FOut {
    static constexpr bool PRE = false; static constexpr bool MID = false; static constexpr int BMAP = 0; static constexpr bool ALIGN = true;
    gfp x; bf16_t* hpre;
    __device__ __forceinline__ void mid(f32x4 (&)[2][2][4][2], const Unit&, int, int, int, int) const {}
    __device__ __forceinline__ void operator()(const f32x4 (&acc)[2][2][4][2], const Unit& u, int wr, int wc, int fr, int fq) const {
        const int rowb = u.pm * BM + wr * 64 + fr, col = u.pn * BM + wc * 32 + 8 * fq;
        f32x4 xa[2][2][2], xb[2][2][2];
#define FO_OFF(gq, m2, bj, n) ((size_t)(rowb + ((gq) >> 1) * HALF + (2 * ((gq) & 1) + (m2)) * 16) * DM + col + (bj) * HALF + 4 * (n))
#define FO_LOAD(S_, gq) _Pragma("unroll") for (int m2 = 0; m2 < 2; ++m2) _Pragma("unroll") for (int bj = 0; bj < 2; ++bj) _Pragma("unroll") for (int n = 0; n < 2; ++n) S_[m2][bj][n] = *(const GAS f32x4*)(x + FO_OFF(gq, m2, bj, n));
#define FO_STORE(S_, gq) _Pragma("unroll") for (int m2 = 0; m2 < 2; ++m2) _Pragma("unroll") for (int bj = 0; bj < 2; ++bj) \
            *(u32x4*)(hpre + FO_OFF(gq, m2, bj, 0)) = pack8(S_[m2][bj][0] * ALPHA + acc[(gq) >> 1][bj][2 * ((gq) & 1) + m2][0], S_[m2][bj][1] * ALPHA + acc[(gq) >> 1][bj][2 * ((gq) & 1) + m2][1]);
        FO_LOAD(xa, 0) FO_LOAD(xb, 1) asm volatile("" ::: "memory");
        FO_STORE(xa, 0) FO_LOAD(xa, 2) asm volatile("" ::: "memory");
        FO_STORE(xb, 1) FO_LOAD(xb, 3) asm volatile("" ::: "memory");
        FO_STORE(xa, 2) asm volatile("" ::: "memory");
        FO_STORE(xb, 3)
#undef FO_OFF
#undef FO_LOAD
#undef FO_STORE
    }
};
struct FGU {
    static constexpr bool PRE = false; static constexpr bool MID = false; static constexpr int BMAP = 0; static constexpr bool ALIGN = true;
    bf16_t* ACT;
    __device__ __forceinline__ void mid(f32x4 (&)[2][2][4][2], const Unit&, int, int, int, int) const {}
    __device__ __forceinline__ void operator()(const f32x4 (&acc)[2][2][4][2], const Unit& u, int wr, int wc, int fr, int fq) const {
        const int rowb = u.pm * BM + wr * 64 + fr, col = u.pn * HALF + wc * 32 + 8 * fq;
        EPI_ROWS( f32x4 o[2];
            _Pragma("unroll") for (int n = 0; n < 2; ++n) _Pragma("unroll") for (int j = 0; j < 4; ++j) { const float gte = acc[ai][0][m][n][j]; o[n][j] = gte * __builtin_amdgcn_rcpf(1.f + __expf(-gte)) * acc[ai][1][m][n][j]; }
            *(u32x4*)(ACT + (size_t)row * FF + col) = pack8(o[0], o[1]); )
    }
};
struct FGU8 {
    static constexpr bool PRE = false; static constexpr bool MID = false; static constexpr int BMAP = 0; static constexpr bool ALIGN = true;
    unsigned char* ACT8;
    __device__ __forceinline__ void mid(f32x4 (&)[2][2][4][2], const Unit&, int, int, int, int) const {}
    __device__ __forceinline__ void operator()(const f32x4 (&acc)[2][2][4][2], const Unit& u, int wr, int wc, int fr, int fq) const {
        const int rowb = u.pm * BM + wr * 64 + fr, col = u.pn * HALF + wc * 32 + 8 * fq;
        EPI_ROWS( f32x4 o[2];
            _Pragma("unroll") for (int n = 0; n < 2; ++n) _Pragma("unroll") for (int j = 0; j < 4; ++j) { const float gte = acc[ai][0][m][n][j]; o[n][j] = gte * __builtin_amdgcn_rcpf(__builtin_fmaf(__builtin_amdgcn_exp2f(gte * -1.44269504f), 1.0f / ACT_SCALE, 1.0f / ACT_SCALE)) * acc[ai][1][m][n][j]; }
            u32x2 pk; pk.x = pack4_fp8(o[0]); pk.y = pack4_fp8(o[1]); *(u32x2*)(ACT8 + (size_t)row * FF + col) = pk; )
    }
};
#ifndef FDOWN_ALIGN
#define FDOWN_ALIGN true
#endif
struct FDown {
    static constexpr bool PRE = true; static constexpr bool MID = false; static constexpr int BMAP = 1; static constexpr bool ALIGN = FDOWN_ALIGN;
    bf16_t* Y; MoeMap mm; int nostore;
    __device__ __forceinline__ void mid(f32x4 (&)[2][2][4][2], const Unit&, int, int, int, int) const {}
    typedef int i32x4_ __attribute__((ext_vector_type(4)));
    mutable i32x4_ ddc0, ddc1, ddn0, ddn1; mutable int dmask, dsb;
    __device__ __forceinline__ void rot() const {
        _Pragma("unroll") for (int m = 0; m < 4; ++m) { const int s0 = (dsb + m * 16) * 9 + 8, s1 = (dsb + HALF + m * 16) * 9 + 8;
            ddc0[m] = dmask < 0 ? s0 : (((dmask >> m) & 1) ? ddn0[m] : -1); ddc1[m] = dmask < 0 ? s1 : (((dmask >> (4 + m)) & 1) ? ddn1[m] : -1); } }
    __device__ __forceinline__ void pre(const Unit& u_, int wr, int fr) const {
        const int pm = u_.pm < 0 ? -1 - u_.pm : u_.pm, rowb = wr * 64 + fr;
        const int e = __builtin_amdgcn_readfirstlane((int)mm.tile_e[pm]); const int base = (pm - __builtin_amdgcn_readfirstlane(mm.tbase[e])) * 256;
        const int es = e == NE ? 0 : e, c = e == NE ? 0 : __builtin_amdgcn_readfirstlane(mm.cnt[es]); const int* lp = mm.list + (size_t)es * T; int mk = 0;
        _Pragma("unroll") for (int m = 0; m < 4; ++m) { const int i0 = base + rowb + m * 16, i1 = i0 + HALF; ddn0[m] = lp[i0 < c ? i0 : 0]; ddn1[m] = lp[i1 < c ? i1 : 0]; mk |= ((i0 < c ? 1 : 0) << m) | ((i1 < c ? 1 : 0) << (4 + m)); }
        dmask = e == NE ? -1 : mk; dsb = base + rowb;
    }
    __device__ __forceinline__ void operator()(const f32x4 (&acc)[2][2][4][2], const Unit& u, int wr, int wc, int fr, int fq) const {
        const int rowb = wr * 64 + fr, col = u.pn * BM + wc * 64 + 16 * fq;
        (void)rowb; EPI_ROWS( (void)row; const int d = nostore ? -1 : (ai ? ddc1[m] : ddc0[m]); if (d >= 0) {
            if (Y_FP8) { u32x4 pk; pk.x = pack4_fp8(acc[ai][0][m][0]); pk.y = pack4_fp8(acc[ai][0][m][1]); pk.z = pack4_fp8(acc[ai][1][m][0]); pk.w = pack4_fp8(acc[ai][1][m][1]);
                *(u32x4*)((unsigned char*)Y + (size_t)d * DM + col) = pk; }
            else { *(u32x4*)(Y + (size_t)d * DM + col) = pack8(acc[ai][0][m][0], acc[ai][0][m][1]); *(u32x4*)(Y + (size_t)d * DM + col + 8) = pack8(acc[ai][1][m][0], acc[ai][1][m][1]); } } )
    }
};
#undef EPI_ROWS
}

namespace att {
typedef short s16x4 __attribute__((ext_vector_type(4)));
constexpr int SLOT = 40960, VOFF = 24576, STG_ROW = 272;
__device__ __forceinline__ void glds16(const void* gsrc, LAS unsigned char* dst) { __builtin_amdgcn_global_load_lds((const unsigned*)gsrc, (LAS unsigned*)dst, 16, 0, 0); }
__device__ __forceinline__ s16x4 vtr(const LAS unsigned char* p) { return __builtin_bit_cast(s16x4, __builtin_amdgcn_ds_read_tr16_b64_v4i16((LAS s16x4*)p)); }
__device__ __forceinline__ float xhalf_max(float m) { auto rr = __builtin_amdgcn_permlane32_swap(__float_as_uint(m), __float_as_uint(m), false, false); return fmaxf(__uint_as_float(rr[0]), __uint_as_float(rr[1])); }
__device__ __forceinline__ float xhalf_sum(float m) { auto rr = __builtin_amdgcn_permlane32_swap(__float_as_uint(m), __float_as_uint(m), false, false); return __uint_as_float(rr[0]) + __uint_as_float(rr[1]); }
__device__ __forceinline__ bf16x8 packp(const f32x16& x, int s) { u32x4 p; p.x = pg8::cvt_pk_bf16(x[8 * s], x[8 * s + 1]); p.y = pg8::cvt_pk_bf16(x[8 * s + 2], x[8 * s + 3]); p.z = pg8::cvt_pk_bf16(x[8 * s + 4], x[8 * s + 5]); p.w = pg8::cvt_pk_bf16(x[8 * s + 6], x[8 * s + 7]); return __builtin_bit_cast(bf16x8, p); }
constexpr float THR = 8.0f;

template <int pf> __device__ __forceinline__ void mla_unit(LAS unsigned char* lds, const bf16_t* __restrict__ Q, const bf16_t* __restrict__ KN, const bf16_t* __restrict__ KR, const bf16_t* __restrict__ VM, bf16_t* __restrict__ O, int b, int h, int qb) {
    int tid = threadIdx.x; asm volatile("" : "+v"(tid));
    const int lane = tid & 63, w = __builtin_amdgcn_readfirstlane(tid >> 6), r = lane & 31, hh = lane >> 5;
    const size_t tb = (size_t)b * SEQ; const int q0 = qb * 256, NT = 4 * (qb + 1), jmax = 4 * qb + (w >> 1);
    const int dkey = 8 * w + (lane >> 3), dch = (lane & 7) ^ ((dkey >> 1) & 7);
    const bf16_t* ks0 = KN + ((tb + dkey) * MH + h) * NOPE + dch * 8;
    const bf16_t* ks2 = KR + (tb + dkey) * ROPE + dch * 8;
    const int vdb = w >> 1, vkq = 2 * (w & 1);
    const bf16_t* vs0 = VM + ((tb + 16 * vkq + (lane >> 2)) * MH + h) * VD + vdb * 32 + (lane & 3) * 8;
#define ATT_DMA(j_, slot_) do { if constexpr ((pf & 8) != 0) break; LAS unsigned char* sb_ = lds + (slot_) * SLOT; const size_t ko_ = (size_t)(j_) * 64 * MH * NOPE, ro_ = (size_t)(j_) * 64 * ROPE; \
        glds16(ks0 + ko_, sb_ + w * 1024); glds16(ks0 + ko_ + 64, sb_ + 8192 + w * 1024); glds16(ks2 + ro_, sb_ + 16384 + w * 1024); \
        glds16(vs0 + ko_, sb_ + VOFF + vdb * 4096 + vkq * 1024); glds16(vs0 + ko_ + (size_t)16 * MH * VD, sb_ + VOFF + vdb * 4096 + (vkq + 1) * 1024); } while (0)
    ATT_DMA(0, 0);
    bf16x8 qf[12];
    { const bf16_t* qp = Q + ((tb + q0 + 32 * w + r) * MH + h) * QKD + 8 * hh;
#pragma unroll
      for (int ks = 0; ks < 12; ++ks) qf[ks] = *(const bf16x8*)(qp + 16 * ks); }
    ATT_DMA(1, 1);
    float mrun = -1e30f, l = 0.f; f32x16 ot[4];
#pragma unroll
    for (int d = 0; d < 4; ++d)
#pragma unroll
        for (int i = 0; i < 16; ++i) ot[d][i] = 0.f;
    int kofs[4];
#pragma unroll
    for (int q = 0; q < 4; ++q) kofs[q] = r * 128 + (((2 * q + hh) ^ ((r >> 1) & 7)) << 4);
    const int vro = VOFF + (4 * hh + ((lane & 15) >> 2)) * 64 + ((lane >> 4) & 1) * 32 + (lane & 3) * 8;
    bf16x8 kf[2][4]; bf16x8 vf[2][4];
#define ATT_LOADK(B_, kb_) do { _Pragma("unroll") for (int i_ = 0; i_ < 2; ++i_) { const int ks_ = 2 * (kb_) + i_; const LAS unsigned char* kp_ = sbk + (ks_ >> 2) * 8192 + kofs[ks_ & 3]; \
        kf[B_][2 * i_] = *(const LAS bf16x8*)(kp_); kf[B_][2 * i_ + 1] = *(const LAS bf16x8*)(kp_ + 4096); } } while (0)
#define ATT_PIN4(A_) asm volatile("" : "+v"(A_[0]), "+v"(A_[1]), "+v"(A_[2]), "+v"(A_[3]) :: "memory")
#define ATT_LOADV(B_, bs_) do { _Pragma("unroll") for (int d_ = 0; d_ < 4; ++d_) { const LAS unsigned char* vp_ = sbv + d_ * 4096 + (bs_) * 1024; const s16x4 lo_ = vtr(vp_), hi_ = vtr(vp_ + 512); \
        vf[B_][d_] = __builtin_shufflevector(lo_, hi_, 0, 1, 2, 3, 4, 5, 6, 7); } } while (0)
    f32x16 x0, x1;
    int slot = 0;
    for (int j = 0; j < NT; ++j) {
        if (j + 1 < NT) asm volatile("s_waitcnt vmcnt(5) lgkmcnt(0)" ::: "memory"); else asm volatile("s_waitcnt vmcnt(0) lgkmcnt(0)" ::: "memory");
        __builtin_amdgcn_s_barrier();
        asm volatile("" ::: "memory");
        if (j + 2 < NT) { const int s2 = slot == 0 ? 2 : slot - 1; ATT_DMA(j + 2, s2); }
        if (j <= jmax) {
            const LAS unsigned char* sbk = lds + slot * SLOT; const LAS unsigned char* sbv = lds + slot * SLOT + vro;
#pragma unroll
            for (int i = 0; i < 16; ++i) { x0[i] = 0.f; x1[i] = 0.f; }
            ATT_LOADK(0, 0);
#pragma unroll
            for (int kb = 0; kb < 6; ++kb) {
                if (kb < 5) ATT_LOADK((kb + 1) & 1, kb + 1); else ATT_LOADV(0, 0);
                ATT_PIN4(kf[kb & 1]);
                if constexpr ((pf & 1) != 0) continue;
                x0 = MFMA32(kf[kb & 1][0], qf[2 * kb], x0); x1 = MFMA32(kf[kb & 1][1], qf[2 * kb], x1);
                x0 = MFMA32(kf[kb & 1][2], qf[2 * kb + 1], x0); x1 = MFMA32(kf[kb & 1][3], qf[2 * kb + 1], x1);
            }
            if (j == jmax) { const int qrel = 32 * (w & 1) + r;
#pragma unroll
                for (int i = 0; i < 16; ++i) { const int k0 = crow(i, hh); if (k0 > qrel) x0[i] = -1e30f; if (k0 + 32 > qrel) x1[i] = -1e30f; } }
            float rm = fmaxf(x0[0], x1[0]);
#pragma unroll
            for (int i = 1; i < 16; ++i) rm = fmaxf(rm, fmaxf(x0[i], x1[i]));
            rm = xhalf_max(rm);
            if (__any(rm > mrun + THR)) { const float mn = fmaxf(mrun, rm), f = __builtin_amdgcn_exp2f(mrun - mn); mrun = mn; l *= f;
#pragma unroll
                for (int d = 0; d < 4; ++d)
#pragma unroll
                    for (int i = 0; i < 16; ++i) ot[d][i] *= f; }
            float ps = 0.f;
#pragma unroll
            for (int i = 0; i < 16; ++i) { if constexpr ((pf & 2) == 0) { x0[i] = __builtin_amdgcn_exp2f(x0[i] - mrun); x1[i] = __builtin_amdgcn_exp2f(x1[i] - mrun); } ps += x0[i] + x1[i]; }
            l += ps;
#pragma unroll
            for (int bs = 0; bs < 4; ++bs) {
                if (bs < 3) ATT_LOADV((bs + 1) & 1, bs + 1);
                ATT_PIN4(vf[bs & 1]);
                const bf16x8 pa = packp((bs >> 1) ? x1 : x0, bs & 1);
                if constexpr ((pf & 4) != 0) continue;
#pragma unroll
                for (int d = 0; d < 4; ++d) ot[d] = MFMA32(vf[bs & 1][d], pa, ot[d]);
            }
        }
        slot = slot == 2 ? 0 : slot + 1;
    }
#undef ATT_LOADK
#undef ATT_PIN4
#undef ATT_LOADV
    l = xhalf_sum(l); const float inv = 1.0f / l;
    asm volatile("s_waitcnt lgkmcnt(0)" ::: "memory");
    __builtin_amdgcn_s_barrier();
    asm volatile("" ::: "memory");
    LAS unsigned char* stg = lds + w * (32 * STG_ROW);
    if (MERGE_FP8) {
        const float sc = inv * O8_SCALE;
#pragma unroll
        for (int d = 0; d < 4; ++d)
#pragma unroll
            for (int gq = 0; gq < 4; ++gq) { const f32x4 q4 = (f32x4){ot[d][4 * gq] * sc, ot[d][4 * gq + 1] * sc, ot[d][4 * gq + 2] * sc, ot[d][4 * gq + 3] * sc};
                *(LAS unsigned*)(stg + r * 144 + (32 * d + 8 * gq + 4 * hh)) = pack4_fp8_(q4); }
        asm volatile("s_waitcnt lgkmcnt(0)" ::: "memory");
        unsigned char* op8 = (unsigned char*)O + (tb + q0 + 32 * w) * DM + h * VD;
#pragma unroll
        for (int it = 0; it < 4; ++it) { const int c = it * 64 + lane, row = c >> 3, ch = c & 7; const u32x4 v = *(const LAS u32x4*)(stg + row * 144 + ch * 16); *(u32x4*)(op8 + (size_t)row * DM + ch * 16) = v; }
    } else {
#pragma unroll
    for (int d = 0; d < 4; ++d)
#pragma unroll
        for (int gq = 0; gq < 4; ++gq) { u32x2 pk; pk.x = pg8::cvt_pk_bf16(ot[d][4 * gq] * inv, ot[d][4 * gq + 1] * inv); pk.y = pg8::cvt_pk_bf16(ot[d][4 * gq + 2] * inv, ot[d][4 * gq + 3] * inv);
            *(LAS u32x2*)(stg + r * STG_ROW + (32 * d + 8 * gq + 4 * hh) * 2) = pk; }
    asm volatile("s_waitcnt lgkmcnt(0)" ::: "memory");
    bf16_t* op = O + (tb + q0 + 32 * w) * DM + h * VD;
#pragma unroll
    for (int it = 0; it < 8; ++it) { const int c = it * 64 + lane, row = c >> 4, ch = c & 15; const u32x4 v = *(const LAS u32x4*)(stg + row * STG_ROW + ch * 16); *(u32x4*)(op + (size_t)row * DM + ch * 8) = v; }
    }
    asm volatile("s_waitcnt lgkmcnt(0)" ::: "memory");
    __builtin_amdgcn_s_barrier();
    asm volatile("" ::: "memory");
#undef ATT_DMA
}
template <int pf> __device__ __forceinline__ void mla_phase(LAS unsigned char* lds, const bf16_t* Q, const bf16_t* KN, const bf16_t* KR, const bf16_t* VM, bf16_t* O, int G, int bid) {
    const int vcu = (G % 8 == 0) ? (bid % 8) * (G / 8) + bid / 8 : bid;
    for (int pu = vcu; pu < NB * MH * 4; pu += G) { const int bh = pu >> 2, s = pu & 3;
        mla_unit<pf>(lds, Q, KN, KR, VM, O, bh >> 3, bh & 7, 7 - s);
        mla_unit<pf>(lds, Q, KN, KR, VM, O, bh >> 3, bh & 7, s); }
}

constexpr int SW_K = 0, SW_V = 32768, SW_LUT = 65536, SW_STG = 65536 + 2048, SW_STG_ROW = 144;
__device__ __forceinline__ void swa_unit(LAS unsigned char* lds, const bf16_t* __restrict__ QS, const bf16_t* __restrict__ KS, const bf16_t* __restrict__ VS, gfp sinks, gfp rel, bf16_t* __restrict__ O, int b, int kvh, int n) {
    int tid = threadIdx.x; asm volatile("" : "+v"(tid));
    const int lane = tid & 63, w = __builtin_amdgcn_readfirstlane(tid >> 6), r = lane & 31, hh = lane >> 5;
    const size_t tb = (size_t)b * SEQ; const int ks0 = n > 0 ? 128 * (n - 1) : 0;
    const int g = w >> 1, hq = kvh * 4 + g;
    { const bf16_t* ksrc = KS + ((tb + ks0 + lane) * SKH + kvh) * SHD + w * 8;
#pragma unroll
      for (int i = 0; i < 4; ++i) glds16(ksrc + (size_t)i * 64 * SKH * SHD, lds + SW_K + w * 4096 + i * 1024);
      const int db = w >> 2; const bf16_t* vsrc = VS + ((tb + ks0 + 64 * (w & 3) + (lane >> 2)) * SKH + kvh) * SHD + db * 32 + (lane & 3) * 8;
#pragma unroll
      for (int i = 0; i < 4; ++i) glds16(vsrc + (size_t)i * 16 * SKH * SHD, lds + SW_V + db * 16384 + (4 * (w & 3) + i) * 1024);
      ((LAS float*)(lds + SW_LUT))[tid] = rel[T5_BUCKET[tid & 127] * SQH + kvh * 4 + (tid >> 7)] * LOG2E; }
    bf16x8 qfa[2][4];
#pragma unroll
    for (int sbq = 0; sbq < 2; ++sbq) { const bf16_t* qp = QS + ((tb + 128 * n + 64 * (w & 1) + 32 * sbq + r) * SQH + hq) * SHD + 8 * hh;
#pragma unroll
        for (int ks = 0; ks < 4; ++ks) qfa[sbq][ks] = *(const bf16x8*)(qp + 16 * ks); }
    asm volatile("s_waitcnt vmcnt(0) lgkmcnt(0)" ::: "memory");
    __builtin_amdgcn_s_barrier();
    asm volatile("" ::: "memory");
    const LAS float* lut = (const LAS float*)(lds + SW_LUT) + g * 128;
    const float sink = sinks[hq] * LOG2E;
    const int kro = hh * 4096 + r * 16, vro = (4 * hh + ((lane & 15) >> 2)) * 64 + ((lane >> 4) & 1) * 32 + (lane & 3) * 8;
    LAS unsigned char* stg = lds + SW_STG + w * (32 * SW_STG_ROW);
#pragma unroll
    for (int sb = 0; sb < 2; ++sb) {
        const int qs = 128 * n + 64 * (w & 1) + 32 * sb;
        f32x16 x[5]; float mx = sink;
        bf16x8 kf[2][4];
#define SW_LOADK(B_, dl_) do { if (qs - 32 * (dl_) >= 0) { const LAS unsigned char* kp_ = lds + SW_K + kro + (qs - 32 * (dl_) - ks0) * 16; \
            _Pragma("unroll") for (int ks_ = 0; ks_ < 4; ++ks_) kf[B_][ks_] = *(const LAS bf16x8*)(kp_ + ks_ * 8192); } } while (0)
        SW_LOADK(0, 0);
#pragma unroll
        for (int dl = 0; dl < 5; ++dl) {
            const int kpos0 = qs - 32 * dl;
            if (dl < 4) SW_LOADK((dl + 1) & 1, dl + 1);
#pragma unroll
            for (int i = 0; i < 16; ++i) x[dl][i] = 0.f;
            if (kpos0 >= 0) {
                asm volatile("" : "+v"(kf[dl & 1][0]), "+v"(kf[dl & 1][1]), "+v"(kf[dl & 1][2]), "+v"(kf[dl & 1][3]) :: "memory");
#pragma unroll
                for (int ks = 0; ks < 4; ++ks) x[dl] = MFMA32(kf[dl & 1][ks], qfa[sb][ks], x[dl]);
#pragma unroll
                for (int i = 0; i < 16; ++i) { const int dist = 32 * dl + r - crow(i, hh); const bool ok = dist >= 0 && dist < 128; const float bias = lut[ok ? dist : 0];
                    x[dl][i] = ok ? x[dl][i] + bias : -1e30f; mx = fmaxf(mx, x[dl][i]); }
            } else {
#pragma unroll
                for (int i = 0; i < 16; ++i) x[dl][i] = -1e30f;
            }
        }
#undef SW_LOADK
        mx = xhalf_max(mx);
        float l = 0.f;
#pragma unroll
        for (int dl = 0; dl < 5; ++dl)
#pragma unroll
            for (int i = 0; i < 16; ++i) { x[dl][i] = __builtin_amdgcn_exp2f(x[dl][i] - mx); l += x[dl][i]; }
        l = xhalf_sum(l) + __builtin_amdgcn_exp2f(sink - mx);
        f32x16 ot[2];
#pragma unroll
        for (int d = 0; d < 2; ++d)
#pragma unroll
            for (int i = 0; i < 16; ++i) ot[d][i] = 0.f;
        bf16x8 vfb[2][4];
#define SW_LOADV(B_, dl_) do { if (qs - 32 * (dl_) >= 0) { _Pragma("unroll") for (int s2_ = 0; s2_ < 2; ++s2_) _Pragma("unroll") for (int d_ = 0; d_ < 2; ++d_) { \
            const LAS unsigned char* vp_ = lds + SW_V + d_ * 16384 + (qs - 32 * (dl_) - ks0 + 16 * s2_) * 64 + vro; const s16x4 lo_ = vtr(vp_), hi_ = vtr(vp_ + 512); \
            vfb[B_][2 * s2_ + d_] = __builtin_shufflevector(lo_, hi_, 0, 1, 2, 3, 4, 5, 6, 7); } } } while (0)
        SW_LOADV(0, 0);
#pragma unroll
        for (int dl = 0; dl < 5; ++dl) {
            const int kpos0 = qs - 32 * dl;
            if (dl < 4) SW_LOADV((dl + 1) & 1, dl + 1);
            if (kpos0 >= 0) {
                asm volatile("" : "+v"(vfb[dl & 1][0]), "+v"(vfb[dl & 1][1]), "+v"(vfb[dl & 1][2]), "+v"(vfb[dl & 1][3]) :: "memory");
#pragma unroll
                for (int s2 = 0; s2 < 2; ++s2) { const bf16x8 pa = packp(x[dl], s2);
#pragma unroll
                    for (int d = 0; d < 2; ++d) ot[d] = MFMA32(vfb[dl & 1][2 * s2 + d], pa, ot[d]); }
            }
        }
#undef SW_LOADV
        const float inv = 1.0f / l;
        if (MERGE_FP8) {
            const float sc = inv * O8_SCALE;
#pragma unroll
            for (int d = 0; d < 2; ++d)
#pragma unroll
                for (int gq = 0; gq < 4; ++gq) { const f32x4 q4 = (f32x4){ot[d][4 * gq] * sc, ot[d][4 * gq + 1] * sc, ot[d][4 * gq + 2] * sc, ot[d][4 * gq + 3] * sc};
                    *(LAS unsigned*)(stg + r * 80 + (32 * d + 8 * gq + 4 * hh)) = pack4_fp8_(q4); }
            asm volatile("s_waitcnt lgkmcnt(0)" ::: "memory");
            unsigned char* op8 = (unsigned char*)O + (tb + qs) * DM + 1024 + hq * SHD;
#pragma unroll
            for (int it = 0; it < 2; ++it) { const int c = it * 64 + lane, row = c >> 2, ch = c & 3; const u32x4 v = *(const LAS u32x4*)(stg + row * 80 + ch * 16); *(u32x4*)(op8 + (size_t)row * DM + ch * 16) = v; }
            asm volatile("s_waitcnt lgkmcnt(0)" ::: "memory");
        } else {
#pragma unroll
        for (int d = 0; d < 2; ++d)
#pragma unroll
            for (int gq = 0; gq < 4; ++gq) { u32x2 pk; pk.x = pg8::cvt_pk_bf16(ot[d][4 * gq] * inv, ot[d][4 * gq + 1] * inv); pk.y = pg8::cvt_pk_bf16(ot[d][4 * gq + 2] * inv, ot[d][4 * gq + 3] * inv);
                *(LAS u32x2*)(stg + r * SW_STG_ROW + (32 * d + 8 * gq + 4 * hh) * 2) = pk; }
        asm volatile("s_waitcnt lgkmcnt(0)" ::: "memory");
        bf16_t* op = O + (tb + qs) * DM + 1024 + hq * SHD;
#pragma unroll
        for (int it = 0; it < 4; ++it) { const int c = it * 64 + lane, row = c >> 3, ch = c & 7; const u32x4 v = *(const LAS u32x4*)(stg + row * SW_STG_ROW + ch * 16); *(u32x4*)(op + (size_t)row * DM + ch * 8) = v; }
        asm volatile("s_waitcnt lgkmcnt(0)" ::: "memory");
        }
    }
    __builtin_amdgcn_s_barrier();
    asm volatile("" ::: "memory");
}
__device__ __forceinline__ void swa_phase(LAS unsigned char* lds, const bf16_t* QS, const bf16_t* KS, const bf16_t* VS, gfp sinks, gfp rel, bf16_t* O, int G, int bid) {
    const int vcu = (G % 8 == 0) ? (bid % 8) * (G / 8) + bid / 8 : bid;
    for (int u = vcu; u < NB * SKH * 16; u += G) { const int n = u & 15, kvh = (u >> 4) & 3, b = u >> 6; swa_unit(lds, QS, KS, VS, sinks, rel, O, b, kvh, n); }
}
}

namespace lnr {
constexpr int A_LO = 65536, P_OFF = 0, LOG_OFF = 32768;
constexpr int SEL_OFF = 131072 + 4096, LCNT_OFF = 131072 + 8192, BASE_OFF = 131072 + 8448, MAXU = 8;
#define MFMA16(a, b, c) __builtin_amdgcn_mfma_f32_16x16x32_bf16((a), (b), (c), 0, 0, 0)
__device__ __forceinline__ void phase(LAS unsigned char* lds, const bf16_t* __restrict__ hpre, gfp g, gfp bta, const bf16_t* __restrict__ WH, const bf16_t* __restrict__ WL,
                                      gfp rbias, bf16_t* __restrict__ HBo, unsigned char* __restrict__ HB8o, float* __restrict__ topwo, int* __restrict__ list, int* __restrict__ dlst, unsigned* __restrict__ cnt, int G, int bid) {
    int tid = threadIdx.x; asm volatile("" : "+v"(tid));
    const int lane = tid & 63, w = __builtin_amdgcn_readfirstlane(tid >> 6);
    constexpr int NU = T / 16;
    LAS int* LCNT = (LAS int*)(lds + LCNT_OFF); LAS int* BASE = (LAS int*)(lds + BASE_OFF); LAS int* SEL = (LAS int*)(lds + SEL_OFF);
    if (tid < 64) LCNT[tid] = 0;
    u32x4 vr[2][4];
    int u = bid, nloc = 0;
    if (u < NU) {
#pragma unroll
        for (int rr = 0; rr < 2; ++rr) { const u32x4* xr = (const u32x4*)(hpre + (size_t)(16 * u + 2 * w + rr) * DM) + lane;
#pragma unroll
            for (int j = 0; j < 4; ++j) vr[rr][j] = xr[64 * j]; }
    }
    const float rb = rbias[lane];
    for (; u < NU && nloc < MAXU; u += G, ++nloc) {
        const int arow = lane & 15, quad = lane >> 4;
        bf16x8 bh[3][4];
        const bf16_t* wb = WH + (size_t)w * 16384 + lane * 8; asm volatile("" : "+v"(wb));
#define LNR_LOADB(S_, ks_) _Pragma("unroll") for (int nb = 0; nb < 4; ++nb) { bh[S_][nb] = *(const bf16x8*)(wb + ((ks_) * 4 + nb) * 512); }
        LNR_LOADB(0, 0) LNR_LOADB(1, 1)
#pragma unroll
        for (int rr = 0; rr < 2; ++rr) {
            const int lr = 2 * w + rr; const size_t row = (size_t)16 * u + lr;
            f32x4 va[4], vb[4]; float s = 0.f;
#pragma unroll
            for (int j = 0; j < 4; ++j) { pg8::unpack8(vr[rr][j], va[j], vb[j]); s += ((va[j].x + va[j].y) + (va[j].z + va[j].w)) + ((vb[j].x + vb[j].y) + (vb[j].z + vb[j].w)); }
            const float mean = wave_sum(s) * (1.f / DM); float s2 = 0.f;
#pragma unroll
            for (int j = 0; j < 4; ++j) { va[j] = va[j] - mean; vb[j] = vb[j] - mean; s2 += ((va[j].x * va[j].x + va[j].y * va[j].y) + (va[j].z * va[j].z + va[j].w * va[j].w)) + ((vb[j].x * vb[j].x + vb[j].y * vb[j].y) + (vb[j].z * vb[j].z + vb[j].w * vb[j].w)); }
            const float rstd = 1.0f / sqrtf(wave_sum(s2) * (1.f / DM) + LN_EPS);
#pragma unroll
            for (int j = 0; j < 4; ++j) {
                const int c = 8 * lane + 512 * j;
                const f32x4 ya = va[j] * rstd * *(const GAS f32x4*)(g + c) + *(const GAS f32x4*)(bta + c), yb = vb[j] * rstd * *(const GAS f32x4*)(g + c + 4) + *(const GAS f32x4*)(bta + c + 4);
                u32x4 oh, ol;
#pragma unroll
                for (int q = 0; q < 2; ++q) { const unsigned ha = pg8::cvt_pk_bf16(ya[2 * q], ya[2 * q + 1]), hb = pg8::cvt_pk_bf16(yb[2 * q], yb[2 * q + 1]); oh[q] = ha; oh[2 + q] = hb;
                    ol[q] = pg8::cvt_pk_bf16(ya[2 * q] - __uint_as_float(ha << 16), ya[2 * q + 1] - __uint_as_float(ha & 0xffff0000u));
                    ol[2 + q] = pg8::cvt_pk_bf16(yb[2 * q] - __uint_as_float(hb << 16), yb[2 * q + 1] - __uint_as_float(hb & 0xffff0000u)); }
                *(u32x4*)(HBo + row * DM + c) = oh;
                if (MOE_FP8) { u32x2 p8; p8.x = pack4_fp8_(ya * H8_SCALE); p8.y = pack4_fp8_(yb * H8_SCALE); *(u32x2*)(HB8o + row * DM + c) = p8; }
                const int off = lr * 4096 + (((lane + 64 * j) ^ lr) << 4);
                *(LAS u32x4*)(lds + off) = oh; *(LAS u32x4*)(lds + A_LO + off) = ol;
            }
        }
        asm volatile("s_waitcnt lgkmcnt(0)" ::: "memory"); __builtin_amdgcn_s_barrier(); asm volatile("" ::: "memory");
        f32x4 acc[4];
#pragma unroll
        for (int nb = 0; nb < 4; ++nb) acc[nb] = (f32x4){0.f, 0.f, 0.f, 0.f};
#define LNR_STEP(S_, ks_) do { asm volatile("" : "+v"(bh[S_][0]), "+v"(bh[S_][1]), "+v"(bh[S_][2]), "+v"(bh[S_][3]) :: "memory");     \
            const int kc = 32 * w + 4 * (ks_) + quad; \
            const bf16x8 a_h = *(const LAS bf16x8*)(lds + arow * 4096 + ((kc ^ arow) << 4)), a_l = *(const LAS bf16x8*)(lds + A_LO + arow * 4096 + ((kc ^ arow) << 4)); \
            _Pragma("unroll") for (int nb = 0; nb < 4; ++nb) { acc[nb] = MFMA16(a_l, bh[S_][nb], acc[nb]); acc[nb] = MFMA16(a_h, bh[S_][nb], acc[nb]); } } while (0)
#pragma unroll
        for (int ks = 0; ks < 8; ++ks) {
            if (ks + 2 < 8) { LNR_LOADB((ks + 2) % 3, ks + 2) }
            LNR_STEP(ks % 3, ks);
        }
#undef LNR_STEP
        { const int un = u + G; if (un < NU && nloc + 1 < MAXU) {
#pragma unroll
            for (int rr = 0; rr < 2; ++rr) { const u32x4* xr = (const u32x4*)(hpre + (size_t)(16 * un + 2 * w + rr) * DM) + lane;
#pragma unroll
                for (int j = 0; j < 4; ++j) vr[rr][j] = xr[64 * j]; } } }
        asm volatile("s_waitcnt lgkmcnt(0)" ::: "memory"); __builtin_amdgcn_s_barrier(); asm volatile("" ::: "memory");
        { LAS float* P = (LAS float*)(lds + P_OFF) + w * 1024;
#pragma unroll
          for (int nb = 0; nb < 4; ++nb)
#pragma unroll
              for (int j = 0; j < 4; ++j) P[(4 * quad + j) * 64 + 16 * nb + arow] = acc[nb][j]; }
        asm volatile("s_waitcnt lgkmcnt(0)" ::: "memory"); __builtin_amdgcn_s_barrier(); asm volatile("" ::: "memory");
        { const LAS float* P = (const LAS float*)(lds + P_OFF); LAS float* LOG = (LAS float*)(lds + LOG_OFF);
#pragma unroll
          for (int o = 0; o < 2; ++o) { const int idx = tid + 512 * o; float sum = P[idx];
#pragma unroll
              for (int ww = 1; ww < 8; ++ww) sum += P[ww * 1024 + idx];
              LOG[idx] = sum; } }
        asm volatile("s_waitcnt lgkmcnt(0)" ::: "memory"); __builtin_amdgcn_s_barrier(); asm volatile("" ::: "memory");
#pragma unroll
        for (int rr = 0; rr < 2; ++rr) {
            const int lr = 2 * w + rr; const int t = 16 * u + lr;
            const float score = sigmoidf_(((const LAS float*)(lds + LOG_OFF))[lr * 64 + lane]); const float sel = score + rb;
            float m1 = sel;
            m1 = fmaxf(m1, __shfl_xor(m1, 1)); m1 = fmaxf(m1, __shfl_xor(m1, 2)); m1 = fmaxf(m1, __shfl_xor(m1, 4));
            int i1 = (sel == m1) ? lane : 64;
            i1 = min(i1, __shfl_xor(i1, 1)); i1 = min(i1, __shfl_xor(i1, 2)); i1 = min(i1, __shfl_xor(i1, 4));
            float m2 = (lane == i1) ? -INFINITY : sel;
            m2 = fmaxf(m2, __shfl_xor(m2, 1)); m2 = fmaxf(m2, __shfl_xor(m2, 2)); m2 = fmaxf(m2, __shfl_xor(m2, 4));
            const float gs = m1 + m2; const int gi = lane >> 3;
            int grank = 0;
#pragma unroll
            for (int gg = 0; gg < 8; ++gg) { const float o = __int_as_float(__builtin_amdgcn_readlane(__float_as_int(gs), 8 * gg)); grank += (o > gs || (o == gs && gg < gi)) ? 1 : 0; }
            const float selm = grank < 4 ? sel : -INFINITY;
            int rank = 0;
#pragma unroll 4
            for (int ll = 0; ll < 64; ++ll) { const float o = __int_as_float(__builtin_amdgcn_readlane(__float_as_int(selm), ll)); rank += (o > selm || (o == selm && ll < lane)) ? 1 : 0; }
            const bool chosen = rank < TOPK;
            const float wsum = wave_sum(chosen ? score : 0.f);
            if (chosen) { const int lrank = atomicAdd((int*)(LCNT + lane), 1); SEL[(nloc * 16 + lr) * 8 + rank] = (lrank << 8) | lane; topwo[(size_t)t * TOPK + rank] = score / wsum * 2.5f; }
        }
        asm volatile("s_waitcnt lgkmcnt(0)" ::: "memory"); __builtin_amdgcn_s_barrier(); asm volatile("" ::: "memory");
    }
    __syncthreads();
    if (tid < 64) BASE[tid] = (int)atomicAdd(cnt + tid, (unsigned)LCNT[tid]);
    __syncthreads();
    for (int idx = tid; idx < nloc * 128; idx += 512) { const int i = idx >> 7, lr = (idx >> 3) & 15, k = idx & 7; const int t = 16 * (bid + i * G) + lr; const int sv = SEL[idx]; const int e = sv & 255, p = BASE[e] + (sv >> 8);
        list[(size_t)e * T + p] = t; dlst[(size_t)e * T + p] = t * 9 + k; }
}
#undef LNR_LOADB
#undef MFMA16
}

__device__ __forceinline__ void final_phase8(const bf16_t* __restrict__ HBp, const unsigned char* __restrict__ Yp, const float* __restrict__ topwp, gfp g, gfp bta, float* __restrict__ outp, int gw, int NGW, int lane) {
    typedef float f32x2_ __attribute__((ext_vector_type(2)));
    for (int t = gw; t < T; t += NGW) {
        u32x4 ry[9][2], rh[2][2];
#pragma unroll
        for (int j = 0; j < 2; ++j) { rh[j][0] = *(const u32x4*)(HBp + (size_t)t * DM + 16 * lane + 1024 * j); rh[j][1] = *(const u32x4*)(HBp + (size_t)t * DM + 16 * lane + 1024 * j + 8); }
#pragma unroll
        for (int k = 0; k < 9; ++k)
#pragma unroll
            for (int j = 0; j < 2; ++j) ry[k][j] = *(const u32x4*)(Yp + ((size_t)t * 9 + k) * DM + 16 * lane + 1024 * j);
        float wk[9];
#pragma unroll
        for (int k = 0; k < 8; ++k) wk[k] = topwp[(size_t)t * 8 + k] * (1.0f / Y_SCALE);
        wk[8] = 1.0f / Y_SCALE;
#pragma unroll
        for (int k = 0; k < 9; ++k)
#pragma unroll
            for (int j = 0; j < 2; ++j) asm volatile("" : "+v"(ry[k][j]));
#pragma unroll
        for (int j = 0; j < 2; ++j) { asm volatile("" : "+v"(rh[j][0])); asm volatile("" : "+v"(rh[j][1])); }
        float v[2][16]; float s = 0.f;
#pragma unroll
        for (int j = 0; j < 2; ++j) { f32x4 a, b, c, d; pg8::unpack8(rh[j][0], a, b); pg8::unpack8(rh[j][1], c, d);
#pragma unroll
            for (int q = 0; q < 4; ++q) { v[j][q] = a[q] * ALPHA; v[j][4 + q] = b[q] * ALPHA; v[j][8 + q] = c[q] * ALPHA; v[j][12 + q] = d[q] * ALPHA; } }
#pragma unroll
        for (int k = 0; k < 9; ++k)
#pragma unroll
            for (int j = 0; j < 2; ++j) { asm volatile("" : "+v"(ry[k][j]));
#pragma unroll
                for (int q = 0; q < 4; ++q) { const int wd = (int)ry[k][j][q]; const f32x2_ lo = __builtin_amdgcn_cvt_pk_f32_fp8(wd, false), hi = __builtin_amdgcn_cvt_pk_f32_fp8(wd, true);
                    v[j][4 * q] += lo[0] * wk[k]; v[j][4 * q + 1] += lo[1] * wk[k]; v[j][4 * q + 2] += hi[0] * wk[k]; v[j][4 * q + 3] += hi[1] * wk[k]; }
                _Pragma("unroll") for (int q = 0; q < 16; ++q) asm volatile("" : "+v"(v[j][q])); }
#pragma unroll
        for (int j = 0; j < 2; ++j)
#pragma unroll
            for (int q = 0; q < 16; q += 4) s += (v[j][q] + v[j][q + 1]) + (v[j][q + 2] + v[j][q + 3]);
        const float mean = wave_sum(s) * (1.f / DM); float s2 = 0.f;
#pragma unroll
        for (int j = 0; j < 2; ++j)
#pragma unroll
            for (int q = 0; q < 16; ++q) { v[j][q] -= mean; s2 += v[j][q] * v[j][q]; }
        const float rstd = 1.0f / sqrtf(wave_sum(s2) * (1.f / DM) + LN_EPS);
#pragma unroll
        for (int j = 0; j < 2; ++j)
#pragma unroll
            for (int q = 0; q < 4; ++q) { const int c = 16 * lane + 1024 * j + 4 * q; const f32x4 gg = *(const GAS f32x4*)(g + c), bb = *(const GAS f32x4*)(bta + c);
                f32x4 o; o[0] = v[j][4 * q] * rstd * gg[0] + bb[0]; o[1] = v[j][4 * q + 1] * rstd * gg[1] + bb[1]; o[2] = v[j][4 * q + 2] * rstd * gg[2] + bb[2]; o[3] = v[j][4 * q + 3] * rstd * gg[3] + bb[3];
                *(f32x4*)(outp + (size_t)t * DM + c) = o; }
    }
}
__device__ __forceinline__ void final_phase(const bf16_t* __restrict__ HBp, const bf16_t* __restrict__ Yp, const float* __restrict__ topwp, gfp g, gfp bta, float* __restrict__ outp, int gw, int NGW, int lane) {
    for (int t = gw; t < T; t += NGW) {
        u32x4 raw[10][4];
#pragma unroll
        for (int j = 0; j < 4; ++j) raw[9][j] = *(const u32x4*)(HBp + (size_t)t * DM + 8 * lane + 512 * j);
#pragma unroll
        for (int k = 0; k < 9; ++k)
#pragma unroll
            for (int j = 0; j < 4; ++j) raw[k][j] = *(const u32x4*)(Yp + ((size_t)t * 9 + k) * DM + 8 * lane + 512 * j);
        float wk[9];
#pragma unroll
        for (int k = 0; k < 8; ++k) wk[k] = topwp[(size_t)t * 8 + k];
        wk[8] = 1.f;
#pragma unroll
        for (int k = 0; k < 10; ++k)
#pragma unroll
            for (int j = 0; j < 4; ++j) asm volatile("" : "+v"(raw[k][j]));
        f32x4 va[4], vb[4]; float s = 0.f;
#pragma unroll
        for (int j = 0; j < 4; ++j) { f32x4 a, b; pg8::unpack8(raw[9][j], a, b); va[j] = a * ALPHA; vb[j] = b * ALPHA; }
#pragma unroll
        for (int k = 0; k < 9; ++k)
#pragma unroll
            for (int j = 0; j < 4; ++j) { f32x4 a, b; pg8::unpack8(raw[k][j], a, b); va[j] += a * wk[k]; vb[j] += b * wk[k]; }
#pragma unroll
        for (int j = 0; j < 4; ++j) s += ((va[j].x + va[j].y) + (va[j].z + va[j].w)) + ((vb[j].x + vb[j].y) + (vb[j].z + vb[j].w));
        const float mean = wave_sum(s) * (1.f / DM); float s2 = 0.f;
#pragma unroll
        for (int j = 0; j < 4; ++j) { va[j] = va[j] - mean; vb[j] = vb[j] - mean; s2 += ((va[j].x * va[j].x + va[j].y * va[j].y) + (va[j].z * va[j].z + va[j].w * va[j].w)) + ((vb[j].x * vb[j].x + vb[j].y * vb[j].y) + (vb[j].z * vb[j].z + vb[j].w * vb[j].w)); }
        const float rstd = 1.0f / sqrtf(wave_sum(s2) * (1.f / DM) + LN_EPS);
#pragma unroll
        for (int j = 0; j < 4; ++j) { const int c = 8 * lane + 512 * j;
            *(f32x4*)(outp + (size_t)t * DM + c) = va[j] * rstd * *(const GAS f32x4*)(g + c) + *(const GAS f32x4*)(bta + c);
            *(f32x4*)(outp + (size_t)t * DM + c + 4) = vb[j] * rstd * *(const GAS f32x4*)(g + c + 4) + *(const GAS f32x4*)(bta + c + 4); }
    }
}

#define XB_TMO      128
#define XB_XCNT(j)  (256  + 64 * (j))
#define XB_XSUB(j)  (1280 + 64 * (j))
#define XB_XGEN(j)  (2304 + 64 * (j))
#define XB_TOP      3328
#define XB_TOPGEN   3392
#define XCD_BAR_WORDS 3456
#define XB_SPIN_CAP (1u << 18)
__device__ __forceinline__ unsigned xb_ld(unsigned* p)              { return __hip_atomic_load(p, __ATOMIC_RELAXED, __HIP_MEMORY_SCOPE_AGENT); }
__device__ __forceinline__ unsigned xb_add(unsigned* p, unsigned v) { return __hip_atomic_fetch_add(p, v, __ATOMIC_RELAXED, __HIP_MEMORY_SCOPE_AGENT); }
__device__ __forceinline__ unsigned xb_xcc_id() { return (unsigned)__builtin_amdgcn_s_getreg((3 << 11) | 20) & 0xFu; }
#define XB_SPIN(cond, bar) do { unsigned _sp = 0; while (cond) { __builtin_amdgcn_s_sleep(1); \
    if ((++_sp & 255u) == 0u) { if (xb_ld(&(bar)[XB_TMO])) break; if (_sp > XB_SPIN_CAP) { atomicAdd(&(bar)[XB_TMO], 1u); break; } } } } while (0)
struct XcdBarrier { unsigned* bar; unsigned x; volatile LAS unsigned* st; };
__device__ __forceinline__ XcdBarrier xcd_barrier_post(unsigned* bar, volatile LAS unsigned* st) {
    XcdBarrier b; b.bar = bar; b.x = xb_xcc_id(); b.st = st;
    if (threadIdx.x == 0) (void)xb_add(&bar[XB_XCNT(b.x)], 1u);
    return b;
}
__device__ __forceinline__ void xcd_barrier_complete(unsigned* bar, unsigned x, unsigned& nloc, unsigned& nx) {
    const unsigned G = gridDim.x * gridDim.y * gridDim.z;
    unsigned sum, cnt, mine, sp = 0u;
    for (;;) {
        sum = 0u; cnt = 0u; mine = 0u;
#pragma unroll
        for (unsigned j = 0; j < 16; ++j) { const unsigned c = xb_ld(&bar[XB_XCNT(j)]); sum += c; cnt += (c > 0u) ? 1u : 0u; mine = (j == x) ? c : mine; }
        if (sum == G) break;
        __builtin_amdgcn_s_sleep(1);
        if ((++sp & 255u) == 0u) { if (xb_ld(&bar[XB_TMO])) break; if (sp > XB_SPIN_CAP) { atomicAdd(&bar[XB_TMO], 1u); break; } }
    }
    nloc = mine > 0u ? mine : 1u; nx = cnt > 0u ? cnt : 1u;
}
__device__ __forceinline__ void xcd_barrier(const XcdBarrier& b) {
    asm volatile("s_waitcnt vmcnt(0)" ::: "memory");
    __syncthreads();
    if (threadIdx.x == 0) {
        unsigned* bar = b.bar;
        __builtin_amdgcn_s_waitcnt(0);
        unsigned nloc = b.st[0], nx = b.st[1];
        if (nloc == 0u) { xcd_barrier_complete(bar, b.x, nloc, nx); b.st[0] = nloc; b.st[1] = nx; }
        const unsigned old = xb_add(&bar[XB_XSUB(b.x)], 1u);
        const unsigned gen = old / nloc;
        if (old + 1u == (gen + 1u) * nloc) {
            __builtin_amdgcn_fence(__ATOMIC_RELEASE, "agent");
            asm volatile("s_waitcnt vmcnt(0)" ::: "memory");
            const unsigned og = xb_add(&bar[XB_TOP], 1u);
            const unsigned tg = og / nx;
            if (og + 1u == (tg + 1u) * nx) xb_add(&bar[XB_TOPGEN], 1u);
            else XB_SPIN(xb_ld(&bar[XB_TOPGEN]) == tg, bar);
            __builtin_amdgcn_fence(__ATOMIC_ACQUIRE, "agent");
            xb_add(&bar[XB_XGEN(b.x)], 1u);
            asm volatile("s_waitcnt vmcnt(0)" ::: "memory");
        } else {
            XB_SPIN(xb_ld(&bar[XB_XGEN(b.x)]) == gen, bar);
            __builtin_amdgcn_fence(__ATOMIC_ACQUIRE, "agent");
            asm volatile("s_waitcnt vmcnt(0)" ::: "memory");
        }
    }
    __syncthreads();
}

constexpr int LDS_BYTES = 147456;
constexpr int MISC_OFF = 131072 + 320;
constexpr int CW_BAR = 4096;
constexpr int NPHASE = 9;
constexpr int TBL_OFF = 131072 + 512, CNTL_OFF = 131072 + 800, TILEE_OFF = 131072 + 1280;
__device__ __forceinline__ int moe_tables(LAS unsigned char* lds, const unsigned* ctl_, int tid) {
    LAS int* base = (LAS int*)(lds + TBL_OFF); LAS int* cl = (LAS int*)(lds + CNTL_OFF); LAS unsigned char* te = lds + TILEE_OFF;
    __syncthreads();
    if (tid < NE) cl[tid] = (int)ctl_[CW_CNT + tid];
    __syncthreads();
    if (tid == 0) { int acc = 0; for (int e = 0; e < NE; ++e) { base[e] = acc; acc += (cl[e] + 255) >> 8; } base[64] = acc; base[65] = acc + T / 256; }
    __syncthreads();
    const int nt = base[65];
    for (int i = tid; i < MAXTILES; i += 512) { int e = 0; if (i < nt) { while (base[e + 1] <= i) ++e; } te[i] = (unsigned char)e; }
    __syncthreads();
    return nt;
}
struct Args { const void* in[24]; float* out; unsigned char* ws; int ph_lo, ph_hi; };
static_assert(sizeof(Args) == 24 * 8 + 8 + 8 + 8, "Args has no padding");
template <int K_> __device__ __forceinline__ const void* inptr() { const void* p; const void* ka = (const void*)__builtin_amdgcn_kernarg_segment_ptr();
    asm volatile("s_load_dwordx2 %0, %1, %2\n\ts_waitcnt lgkmcnt(0)" : "=s"(p) : "s"(ka), "i"(K_ * 8) : "memory");
    return p; }
__device__ __forceinline__ int fresh_tid() { int t = threadIdx.x; asm volatile("" : "+v"(t)); return t; }
__device__ __forceinline__ int fresh_bid() { int b = blockIdx.x; asm volatile("" : "+s"(b)); return b; }
#define x_ ((gfp)inptr<0>())
#define positions_  ((gip)inptr<1>())
#define w_in_ ((gfp)inptr<2>())
#define b_gate_ ((gfp)inptr<3>())
#define q_norm_g_ ((gfp)inptr<4>())
#define kv_norm_g_ ((gfp)inptr<5>())
#define w_uq_ ((gfp)inptr<6>())
#define w_uk_ ((gfp)inptr<7>())
#define w_uv_ ((gfp)inptr<8>())
#define swa_sinks_ ((gfp)inptr<9>())
#define rel_table_ ((gfp)inptr<10>())
#define w_br_mla_ ((gfp)inptr<11>())
#define w_br_swa_ ((gfp)inptr<12>())
#define w_out_ ((gfp)inptr<13>())
#define ln1_g_ ((gfp)inptr<14>())
#define ln1_b_ ((gfp)inptr<15>())
#define w_router_ ((gfp)inptr<16>())
#define router_bias_ ((gfp)inptr<17>())
#define w_gate_up_ ((gfp)inptr<18>())
#define w_down_ ((gfp)inptr<19>())
#define w_sgu_ ((gfp)inptr<20>())
#define w_sdn_ ((gfp)inptr<21>())
#define ln2_g_ ((gfp)inptr<22>())
#define ln2_b_ ((gfp)inptr<23>())
#define ctl      ((unsigned*)(ws + OFF_CTL))
#define ropec    ((float*)(ws + OFF_ROPEC))
#define ropes    ((float*)(ws + OFF_ROPES))
#define ssq      ((float*)(ws + OFF_SSQ))
#define topw     ((float*)(ws + OFF_TOPKW))
#define elist    ((int*)(ws + OFF_LIST))
#define dlist    ((int*)(ws + OFF_DLIST))
#define WRH      ((bf16_t*)(ws + OFF_WR))
#define WRL      (((bf16_t*)(ws + OFF_WR)) + NE * DM)
#define WUQ      ((bf16_t*)(ws + OFF_WUQ))
#define WUKV     ((bf16_t*)(ws + OFF_WUKV))
#define WBR      ((bf16_t*)(ws + OFF_WBR))
#define WOUT     ((bf16_t*)(ws + OFF_WOUT))
#define WIN      ((bf16_t*)(ws + OFF_WIN))
#define WDN      ((bf16_t*)(ws + OFF_WDN))
#define WGU      ((bf16_t*)(ws + OFF_WGU))
#define HB       ((bf16_t*)(ws + OFF_HB))
#define HB8      ((unsigned char*)(ws + OFF_HB8))
#define ACT      ((bf16_t*)(ws + OFF_ACT))
#define XB       ((bf16_t*)(ws + OFF_XB))
#define CQ       ((bf16_t*)(ws + OFF_CQ))
#define CKV      ((bf16_t*)(ws + OFF_CKV))
#define QS       ((bf16_t*)(ws + OFF_QS))
#define KS       ((bf16_t*)(ws + OFF_KS))
#define VS       ((bf16_t*)(ws + OFF_VS))
#define KR       ((bf16_t*)(ws + OFF_KR))
#define RT       ((bf16_t*)(ws + OFF_RT))
#define G1       ((bf16_t*)(ws + OFF_G1))
#define Q        ((bf16_t*)(ws + OFF_Q))
#define KN       ((bf16_t*)(ws + OFF_KN))
#define VM       ((bf16_t*)(ws + OFF_VM))
#define O        ((bf16_t*)(ws + OFF_O))
#define MG       ((bf16_t*)(ws + OFF_MG))
#define HPRE     ((bf16_t*)(ws + OFF_HPRE))
#define Y        ((bf16_t*)(ws + OFF_Y))
#define PHASE_IDS() const int tid = fresh_tid(), bid = fresh_bid(); const int lane = tid & 63, wave = __builtin_amdgcn_readfirstlane(tid >> 6); \
    const int vtid = tid & 255, vb0 = bid * 2 + (tid >> 8), nvb = G * 2, gw = bid * 8 + wave, NGW = G * 8; (void)lane; (void)wave; (void)vtid; (void)vb0; (void)nvb; (void)gw; (void)NGW

__global__ void __launch_bounds__(512, 2) mega(Args args) {
    extern __shared__ __attribute__((aligned(16))) unsigned char lds_raw[];
    LAS unsigned char* lds = (LAS unsigned char*)lds_raw;
    const int G = gridDim.x;
    unsigned char* ws = args.ws; float* out = args.out;
    { const int tid = threadIdx.x;
    for (int u = tid; u < (LDS_BYTES - 131072) / 4; u += 512) ((LAS unsigned*)(lds + 131072))[u] = 0u;
    __syncthreads(); }
    const XcdBarrier bar = xcd_barrier_post(ctl + CW_BAR, (volatile LAS unsigned*)(lds + MISC_OFF) + 8);
    const int lo = args.ph_lo, hi = args.ph_hi & 0xffff, variant = args.ph_hi >> 16; (void)variant;
#ifndef ONLY_PHASE
#define ONLY_PHASE -1
#endif
#define IN(k) ((ONLY_PHASE < 0 || ONLY_PHASE == (k)) && lo <= (k) && (k) < hi)
#define SEAM(k) do { if (IN(k) && IN((k) + 1)) xcd_barrier(bar); } while (0)

    if (IN(0)) { PHASE_IDS();
        LAS unsigned char* scr = lds + wave * 8192;
#define TRANSPOSE(Map, W_, K_, Nsrc_, WT_, Nout_, ldo_, koff_, ks_, Z_, wstride_, ostride_) do { const int per_ = ((K_) / 64) * ((Nout_) / 64), n_ = per_ * (Z_); \
        for (int it = gw; it < n_; it += NGW) { const int z_ = it / per_; transpose_item<Map>((W_) + (size_t)z_ * (wstride_), K_, Nsrc_, (WT_) + (size_t)z_ * (ostride_), Nout_, ldo_, koff_, ks_, scr, it % per_, lane); } } while (0)
        if (PROJ_FP8) { for (int it = gw; it < (DM / 64) * (NPROJ / 64); it += NGW) transpose_item8<MapWin>(w_in_, DM, 6464, (unsigned char*)WIN, NPROJ, DM, 0, W8_SCALE, scr, it, lane); }
        else if (!GATE_FP8) TRANSPOSE(MapWin, w_in_, DM, 6464, WIN, NPROJ, DM, 0, (gfp)nullptr, 1, 0, 0);
        else TRANSPOSE(MapWinA, w_in_, DM, 6464, WIN, 2560, DM, 0, (gfp)nullptr, 1, 0, 0);
#define TRANSPOSE8(Map, W_, K_, Nsrc_, WT_, Nout_, Z_, wstride_, ostride_) do { const int per_ = ((K_) / 64) * ((Nout_) / 64), n_ = per_ * (Z_); \
        for (int it = gw; it < n_; it += NGW) { const int z_ = it / per_; transpose_item8<Map>((W_) + (size_t)z_ * (wstride_), K_, Nsrc_, (unsigned char*)(WT_) + (size_t)z_ * (ostride_), Nout_, K_, 0, W8_SCALE, scr, it % per_, lane); } } while (0)
#define TPIPE8(Map, W_, K_, Nsrc_, WT_, Nout_, Z_, wstride_, ostride_) do { const int per_ = ((K_) / 64) * ((Nout_) / 64), n_ = per_ * (Z_); f32x4 va_[16], vb_[16]; \
        int it_ = gw; if (it_ < n_) t8_load<Map>((W_) + (size_t)(it_ / per_) * (wstride_), Nsrc_, Nout_, it_ % per_, lane, va_); \
        for (; it_ < n_; it_ += 2 * NGW) { const int i1_ = it_ + NGW, i2_ = it_ + 2 * NGW; \
            if (i1_ < n_) t8_load<Map>((W_) + (size_t)(i1_ / per_) * (wstride_), Nsrc_, Nout_, i1_ % per_, lane, vb_); \
            t8_proc(va_, (unsigned char*)(WT_) + (size_t)(it_ / per_) * (ostride_), Nout_, K_, W8_SCALE, scr, it_ % per_, lane); \
            if (i1_ < n_) { if (i2_ < n_) t8_load<Map>((W_) + (size_t)(i2_ / per_) * (wstride_), Nsrc_, Nout_, i2_ % per_, lane, va_); \
                t8_proc(vb_, (unsigned char*)(WT_) + (size_t)(i1_ / per_) * (ostride_), Nout_, K_, W8_SCALE, scr, i1_ % per_, lane); } } } while (0)
        if (GATE_FP8 && !PROJ_FP8) TRANSPOSE8(MapWinG, w_in_, DM, 6464, (unsigned char*)WIN + (size_t)2560 * DM * 2, 4096, 1, 0, 0);
        if (MOE_FP8 && NE_GU0 > 0 && !(variant & 16)) TPIPE8(MapGU, w_gate_up_, DM, 1024, WGU, 1024, NE_GU0, (size_t)DM * 1024, (size_t)1024 * DM);
        if (!MOE_FP8) {
        TRANSPOSE(MapGU, w_gate_up_, DM, 1024, WGU, 1024, DM, 0, (gfp)nullptr, NE, (size_t)DM * 1024, (size_t)1024 * DM);
        TRANSPOSE(MapGU, w_sgu_, DM, 1024, WGU + (size_t)NE * 1024 * DM, 1024, DM, 0, (gfp)nullptr, 1, 0, 0);
        TRANSPOSE(MapId, w_down_, FF, DM, WDN, DM, FF, 0, (gfp)nullptr, NE, (size_t)FF * DM, (size_t)DM * FF);
        TRANSPOSE(MapId, w_sdn_, FF, DM, WDN + (size_t)NE * DM * FF, DM, FF, 0, (gfp)nullptr, 1, 0, 0);
        }
        if (!(variant & 32)) { gfp xp = x_; bf16_t* xb = XB; const size_t NTH = (size_t)G * 512, t0 = (size_t)bid * 512 + tid;
          for (size_t e = t0; e < (size_t)T * DM / 8; e += 4 * NTH) { f32x4 a[4], b[4];
#pragma unroll
              for (int u = 0; u < 4; ++u) { const size_t i = (e + u * NTH) * 8; if (i < (size_t)T * DM) { a[u] = __builtin_nontemporal_load((const GAS f32x4*)(xp + i)); b[u] = __builtin_nontemporal_load((const GAS f32x4*)(xp + i + 4)); } }
#pragma unroll
              for (int u = 0; u < 4; ++u) { const size_t i = (e + u * NTH) * 8; if (i < (size_t)T * DM) { if (!PROJ_FP8) *(u32x4*)(xb + i) = pg8::pack8(a[u], b[u]);
                  if (GATE_FP8 || PROJ_FP8) { u32x2 p8; p8.x = pack4_fp8_(a[u] * H8_SCALE); p8.y = pack4_fp8_(b[u] * H8_SCALE); *(u32x2*)(HB8 + i) = p8; } } } } }
        for (int vb = vb0; vb < T * 32 / 256; vb += nvb) b_rope_table(vb, vtid, positions_, ropec, ropes);
    }
    SEAM(0);
    if (IN(1)) { PHASE_IDS();
        const int GG = (G == 256 && MOE_FP8) ? CONV_SPLIT : G;
#define CONV_ALL() do { LAS unsigned char* scr = lds + wave * 8192; \
            conv_dynamic<MapGU>(w_gate_up_, w_sgu_, DM, 1024, (unsigned char*)WGU, ctl + CW_CONV, scr, lane); \
            conv_dynamic<MapId>(w_down_, w_sdn_, FF, DM, (unsigned char*)WDN, ctl + CW_CONV + 32, scr, lane); } while (0)
        if (bid < GG && !(variant & 64)) {
        if (PROJ_FP8) { pg8::Gemm g{HB8, WIN, {}, DM, (variant >> 1) & 7, E8_ACT, E8_W}; pg8::StaticOrder S; S.init(T, NPROJ, DM, GG, bid); pg8::FProj e{CQ, CKV, QS, KS, VS, KR, RT, G1, b_gate_, ropec, ropes, ssq, 0}; pg8::gemm_phase<false, 1>(lds, g, S, e); }
        else if (!GATE_FP8) { pg8::Gemm g{XB, WIN, {}, DM, (variant >> 1) & 7, 0u, 0u}; pg8::StaticOrder S; S.init(T, NPROJ, DM, G, bid); pg8::FProj e{CQ, CKV, QS, KS, VS, KR, RT, G1, b_gate_, ropec, ropes, ssq, 0}; pg8::gemm_phase<false, 2>(lds, g, S, e); }
        else {
            { pg8::Gemm g{XB, WIN, {}, DM, (variant >> 1) & 7, 0u, 0u}; pg8::StaticOrder S; S.init(T, 2560, DM, G, bid); pg8::FProj e{CQ, CKV, QS, KS, VS, KR, RT, G1, b_gate_, ropec, ropes, ssq, 1}; pg8::gemm_phase<false, 2>(lds, g, S, e); }
            { pg8::Gemm g{HB8, (unsigned char*)WIN + (size_t)2560 * DM * 2, {}, DM, (variant >> 1) & 7, E8_ACT, E8_W}; pg8::StaticOrder S; S.init(T, 4096, DM, G, bid); pg8::FProj e{CQ, CKV, QS, KS, VS, KR, RT, G1, b_gate_, ropec, ropes, ssq, 2}; pg8::gemm_phase<false, 1>(lds, g, S, e); }
        }
        __syncthreads(); }
#if CONV_DYNAMIC
        if (MOE_FP8 && !(variant & 16)) CONV_ALL(); }
#else
        if (MOE_FP8 && !(variant & 16) && (bid >= GG || GG == G)) { LAS unsigned char* scr = lds + wave * 8192; const int gwc_ = GG == G ? gw : (bid - GG) * 8 + wave, ngwc_ = GG == G ? NGW : (G - GG) * 8;
            { const int gw = gwc_, NGW = ngwc_;
        TRANSPOSE(MapWuq, w_uq_, QR, 1536, WUQ, 1536, QR, 0, q_norm_g_, 1, 0, 0);
        TRANSPOSE(MapId, w_uk_, KVR, 1024, WUKV, 1024, KVR, 0, kv_norm_g_, 1, 0, 0);
        TRANSPOSE(MapId, w_uv_, KVR, 1024, WUKV + 1024 * KVR, 1024, KVR, 0, kv_norm_g_, 1, 0, 0);
        if (!MERGE_FP8) {
        TRANSPOSE(MapId, w_br_mla_, 1024, DM, WBR, DM, DM, 0, (gfp)nullptr, 1, 0, 0);
        TRANSPOSE(MapId, w_br_swa_, 1024, DM, WBR, DM, DM, 1024, (gfp)nullptr, 1, 0, 0);
        } else {
            for (int it = gw; it < 16 * 32; it += NGW) transpose_item8<MapId>(w_br_mla_, 1024, DM, (unsigned char*)WBR, DM, DM, 0, W8_SCALE, scr, it, lane);
            for (int it = gw; it < 16 * 32; it += NGW) transpose_item8<MapId>(w_br_swa_, 1024, DM, (unsigned char*)WBR, DM, DM, 1024, W8_SCALE, scr, it, lane);
        }
        if (!MIX_FP8) TRANSPOSE(MapId, w_out_, DM, DM, WOUT, DM, DM, 0, (gfp)nullptr, 1, 0, 0);
        else { for (int it = gw; it < 32 * 32; it += NGW) transpose_item8<MapId>(w_out_, DM, DM, (unsigned char*)WOUT, DM, DM, 0, WOUT8_SCALE, scr, it, lane); }
            { const int vb0c_ = GG == G ? vb0 : (bid - GG) * 2 + (tid >> 8), nvbc_ = GG == G ? nvb : (G - GG) * 2; for (int vb = vb0c_; vb < NE * DM / 256; vb += nvbc_) b_router_split(vb, vtid, w_router_, WRH, WRL); }
            conv_static3<MapGU>(w_gate_up_ + (size_t)NE_GU0 * DM * 1024, (size_t)DM * 1024, 1024, (unsigned char*)WGU + (size_t)NE_GU0 * 1024 * DM, (size_t)1024 * DM, 1024, DM, NE - NE_GU0, gw, NGW, scr, lane);
            TRANSPOSE8(MapGU, w_sgu_, DM, 1024, (unsigned char*)WGU + (size_t)NE * 1024 * DM, 1024, 1, 0, 0);
            conv_static3<MapId>(w_down_, (size_t)FF * DM, DM, (unsigned char*)WDN, (size_t)DM * FF, DM, FF, NE, gw, NGW, scr, lane);
            TRANSPOSE8(MapId, w_sdn_, FF, DM, (unsigned char*)WDN + (size_t)NE * DM * FF, DM, 1, 0, 0); } } }
#endif
#undef CONV_ALL
#undef TRANSPOSE8
#undef TPIPE8
#undef TRANSPOSE
    SEAM(1);
    if (IN(2)) { PHASE_IDS();
        { pg8::Gemm g{CQ, WUQ, {}, QR, (variant >> 1) & 7, 0u, 0u}; pg8::StaticOrder S; S.init(T, 1536, QR, G, bid); pg8::FQ e{Q, ssq, ropec, ropes}; pg8::gemm_phase<false, 2>(lds, g, S, e); }
        { pg8::Gemm g{CKV, WUKV, {}, KVR, (variant >> 1) & 7, 0u, 0u}; pg8::StaticOrder S; S.init(T, 2048, KVR, G, bid); pg8::FKV e{KN, VM, ssq}; pg8::gemm_phase<false, 2>(lds, g, S, e); }
    }
    SEAM(2);
    if (IN(3)) { PHASE_IDS();
        #ifdef MLA_PF
        if (variant >> 4) att::mla_phase<MLA_PF>(lds, Q, KN, KR, VM, O, G, bid); else
#endif
        if (!(variant & 4)) att::mla_phase<0>(lds, Q, KN, KR, VM, O, G, bid);
        if (!(variant & 8)) att::swa_phase(lds, QS, KS, VS, swa_sinks_, rel_table_, O, G, bid);
    }
    SEAM(3);
    if (IN(4)) { PHASE_IDS(); pg8::StaticOrder S; S.init(T, DM, DM, G, bid); pg8::FMerge e{RT, G1, MG};
        if (MERGE_FP8) { pg8::Gemm g{O, WBR, {}, DM, (variant >> 1) & 7, E8_W, E8_W}; pg8::gemm_phase<false, 1>(lds, g, S, e); }
        else { pg8::Gemm g{O, WBR, {}, DM, (variant >> 1) & 7, 0u, 0u}; pg8::gemm_phase<false, 2>(lds, g, S, e); } }
    SEAM(4);
    if (IN(5)) { PHASE_IDS(); pg8::StaticOrder S; S.init(T, DM, DM, G, bid); pg8::FOut e{x_, HPRE};
        if (MIX_FP8) { pg8::Gemm g{MG, WOUT, {}, DM, (variant >> 1) & 7, E8_W, E8_W}; pg8::gemm_phase<false, 1>(lds, g, S, e); }
        else { pg8::Gemm g{MG, WOUT, {}, DM, (variant >> 1) & 7, 0u, 0u}; pg8::gemm_phase<false, 2>(lds, g, S, e); } }
    SEAM(5);
    if (IN(6)) { PHASE_IDS(); lnr::phase(lds, HPRE, ln1_g_, ln1_b_, WRH, WRL, router_bias_, HB, HB8, topw, elist, dlist, ctl + CW_CNT, G, bid); }
    SEAM(6);
    if (IN(7)) { PHASE_IDS(); const int ntl = moe_tables(lds, ctl, tid); const pg8::MoeMap mm{elist, (const LAS int*)(lds + TBL_OFF), (const LAS int*)(lds + CNTL_OFF), lds + TILEE_OFF};
        pg8::MoeOrder S{ntl, 4, G, bid, DM, (size_t)1024 * DM, lds + TILEE_OFF};
        if (MOE_FP8) { pg8::Gemm g{HB8, WGU, mm, DM, (variant >> 1) & 7, E8_ACT, E8_W}; pg8::FGU8 e{(unsigned char*)ACT}; pg8::gemm_phase<true, 1>(lds, g, S, e); }
        else { pg8::Gemm g{HB, WGU, mm, DM, (variant >> 1) & 7, 0u, 0u}; pg8::FGU e{ACT}; pg8::gemm_phase<true, 2>(lds, g, S, e); } }
    SEAM(7);
    if (IN(8)) { PHASE_IDS(); const int ntl = moe_tables(lds, ctl, tid); const pg8::MoeMap mm{dlist, (const LAS int*)(lds + TBL_OFF), (const LAS int*)(lds + CNTL_OFF), lds + TILEE_OFF};
        pg8::MoeOrder S{ntl, 8, G, bid, FF, (size_t)DM * FF, lds + TILEE_OFF}; pg8::FDown e{Y, mm, variant & 1};
        if (MOE_FP8) { pg8::Gemm g{ACT, WDN, {}, FF, (variant >> 1) & 7, Y_FP8 ? E8_ACTY : E8_ACT, E8_W}; pg8::gemm_phase<false, 1>(lds, g, S, e); }
        else { pg8::Gemm g{ACT, WDN, {}, FF, (variant >> 1) & 7, 0u, 0u}; pg8::gemm_phase<false, 2>(lds, g, S, e); } }
    SEAM(8);
    if (IN(9)) { PHASE_IDS(); if (Y_FP8) final_phase8(HB, (const unsigned char*)Y, topw, ln2_g_, ln2_b_, out, gw, NGW, lane); else final_phase(HB, Y, topw, ln2_g_, ln2_b_, out, gw, NGW, lane); }
#undef IN
#undef SEAM
}

#undef x_
#undef ctl
#undef O
#undef Q
#undef Y
extern "C" void kernel_launch(void* const* d_in, const int* in_sizes, int n_in, void* d_out, int out_size, void* d_ws, size_t ws_size, hipStream_t stream) {
    static int grid = 0;
    if (grid == 0) {
        if (n_in != 24 || out_size != T * DM || ws_size < WS_NEED) { fprintf(stderr, "kernel_launch: unexpected problem (n_in %d, out %d, ws %zu < %zu)\n", n_in, out_size, ws_size, (size_t)WS_NEED); grid = -1; return; }
        int dev = 0, cus = 0;
        if (hipGetDevice(&dev) != hipSuccess || hipDeviceGetAttribute(&cus, hipDeviceAttributeMultiprocessorCount, dev) != hipSuccess) { grid = -1; return; }
        if (hipFuncSetAttribute((const void*)mega, hipFuncAttributeMaxDynamicSharedMemorySize, LDS_BYTES) != hipSuccess) { fprintf(stderr, "kernel_launch: hipFuncSetAttribute failed\n"); grid = -1; return; }
        int per_cu = 0;
        if (hipOccupancyMaxActiveBlocksPerMultiprocessor(&per_cu, (const void*)mega, 512, LDS_BYTES) != hipSuccess || per_cu < 1) fprintf(stderr, "kernel_launch: occupancy query reports %d\n", per_cu);
        (void)hipGetLastError();
        grid = cus;
    }
    if (grid < 0) return;
    (void)hipMemsetAsync((char*)d_ws + OFF_CTL, 0, 1 * MiB, stream);
    Args a; memset(&a, 0, sizeof(a));
    for (int i = 0; i < 24; ++i) a.in[i] = d_in[i];
    a.out = (float*)d_out; a.ws = (unsigned char*)d_ws; a.ph_lo = 0; a.ph_hi = NPHASE + 1;
    hipLaunchKernelGGL(mega, dim3(grid), dim3(512), LDS_BYTES, stream, a);
#ifdef PROBE_PHASE
#ifndef PROBE_VARIANT
#define PROBE_VARIANT 0
#endif
    a.ph_lo = PROBE_PHASE; a.ph_hi = (PROBE_PHASE + 1) | (PROBE_VARIANT << 16);
    hipLaunchKernelGGL(mega, dim3(grid), dim3(512), LDS_BYTES, stream, a);
#endif
}
```

```cpp
#include <hip/hip_runtime.h>
#include <cstdint>
#include <cstdio>
#include <cstring>

typedef unsigned short bf16_t;
typedef short bf16x8 __attribute__((ext_vector_type(8)));
typedef float f32x16 __attribute__((ext_vector_type(16)));
typedef float f32x4 __attribute__((ext_vector_type(4)));
typedef unsigned u32x4 __attribute__((ext_vector_type(4)));
typedef unsigned u32x2 __attribute__((ext_vector_type(2)));

#ifndef CONV_SPLIT
#define CONV_SPLIT 192
#endif
#ifndef NE_GU0
#define NE_GU0 0
#endif
#ifndef CONV_DYNAMIC
#define CONV_DYNAMIC 0
#endif
constexpr int NB = 16, SEQ = 2048, T = NB * SEQ, DM = 2048;
constexpr int QR = 512, KVR = 256, ROPE = 64, NOPE = 128, VD = 128, MH = 8, QKD = NOPE + ROPE;
constexpr int SQH = 16, SKH = 4, SHD = 64;
constexpr int NE = 64, TOPK = 8, FF = 512;
constexpr int NPROJ = 6656;
constexpr float ALPHA = 1.189207115002721f;
constexpr float LN_EPS = 1e-5f, RMS_EPS = 1e-6f;
constexpr float LOG2E = 1.4426950408889634f;
constexpr float MLA_QSCALE = 0.07216878364870322f * LOG2E;
constexpr float SWA_QSCALE = 0.125f * LOG2E;
#ifndef MOE_FP8
#define MOE_FP8 1
#endif
#ifndef GATE_FP8
#define GATE_FP8 1
#endif
#ifndef PROJ_FP8
#define PROJ_FP8 1
#endif
#ifndef MERGE_FP8
#define MERGE_FP8 1
#endif
#ifndef MIX_FP8
#define MIX_FP8 1
#endif
#ifndef GATE8
#define GATE8 1
#endif
constexpr float G18_SCALE = 32.0f;
#ifndef Y_FP8
#define Y_FP8 1
#endif
constexpr float H8_SCALE = 4.0f, ACT_SCALE = 4.0f, W8_SCALE = 32.0f, Y_SCALE = 8.0f;
constexpr unsigned E8_ACTY = 0x80808080u  ;
static_assert(Y_SCALE == 8.0f && ACT_SCALE == 4.0f, "E8_ACTY encodes Y_SCALE / ACT_SCALE = 2");
constexpr unsigned E8_ACT = 0x7d7d7d7du  , E8_W = 0x7a7a7a7au  , E8_16 = 0x7b7b7b7bu  , E8_64 = 0x79797979u  ;
constexpr float O8_SCALE = 32.0f, MG8_SCALE = 32.0f, WOUT8_SCALE = 32.0f;
constexpr int MAXTILES = 1216;
constexpr int NSLOT = MAXTILES * 256;

constexpr size_t MiB = 1ull << 20;
constexpr size_t OFF_CTL = 0;
constexpr size_t OFF_ROPEC = 1 * MiB, OFF_ROPES = 5 * MiB;
constexpr size_t OFF_SSQ = 9 * MiB;
constexpr size_t OFF_TOPKW = 11 * MiB;
constexpr size_t OFF_DLIST = 12 * MiB;
constexpr size_t OFF_WR = 21 * MiB;
constexpr size_t OFF_LIST = 22 * MiB;
constexpr size_t OFF_WUQ = 30 * MiB;
constexpr size_t OFF_WUKV = 32 * MiB;
constexpr size_t OFF_WBR = 33 * MiB;
constexpr size_t OFF_WOUT = 41 * MiB;
constexpr size_t OFF_WIN = 49 * MiB;
constexpr size_t OFF_WDN = 75 * MiB;
constexpr size_t OFF_HB8 = 141 * MiB;
constexpr size_t OFF_HB = 205 * MiB;
constexpr size_t OFF_ACT = 333 * MiB;
constexpr size_t OFF_WGU = 637 * MiB;
constexpr size_t OFF_XB = 1025 * MiB;
constexpr size_t OFF_CQ = 1153 * MiB;
constexpr size_t OFF_CKV = 1185 * MiB;
constexpr size_t OFF_QS = 1201 * MiB;
constexpr size_t OFF_KS = 1265 * MiB;
constexpr size_t OFF_VS = 1281 * MiB;
constexpr size_t OFF_KR = 1297 * MiB;
constexpr size_t OFF_RT = 1301 * MiB;
constexpr size_t OFF_G1 = 1429 * MiB;
constexpr size_t OFF_Q = 1557 * MiB;
constexpr size_t OFF_KN = 1653 * MiB;
constexpr size_t OFF_VM = 1717 * MiB;
constexpr size_t OFF_O = 1781 * MiB;
constexpr size_t OFF_MG = 1909 * MiB;
constexpr size_t OFF_HPRE = OFF_RT;
constexpr size_t OFF_Y = OFF_WGU;
constexpr size_t WS_NEED = 2037 * MiB;
static_assert(OFF_Y + (size_t)T * 9 * 2048 * 2 <= WS_NEED, "Y overlay");
constexpr int CW_CNT = 0, CW_TBASE = 128, CW_NT = 256, CW_CONV = 1024;

__device__ __forceinline__ unsigned f2bf(float f) { unsigned u = __float_as_uint(f); return (u + 0x7fffu + ((u >> 16) & 1u)) >> 16; }
__device__ __forceinline__ float bf2f(bf16_t b) { return __uint_as_float((unsigned)b << 16); }
__device__ __forceinline__ int crow(int i, int h) { return (i & 3) + 8 * (i >> 2) + 4 * h; }
__device__ __forceinline__ float wave_sum(float v) {
    v += __int_as_float(__builtin_amdgcn_update_dpp(0, __float_as_int(v), 0xB1, 0xF, 0xF, true));
    v += __int_as_float(__builtin_amdgcn_update_dpp(0, __float_as_int(v), 0x4E, 0xF, 0xF, true));
    v += __int_as_float(__builtin_amdgcn_update_dpp(0, __float_as_int(v), 0x141, 0xF, 0xF, true));
    v += __int_as_float(__builtin_amdgcn_update_dpp(0, __float_as_int(v), 0x140, 0xF, 0xF, true));
    const float r0 = __int_as_float(__builtin_amdgcn_readlane(__float_as_int(v), 0)), r1 = __int_as_float(__builtin_amdgcn_readlane(__float_as_int(v), 16));
    const float r2 = __int_as_float(__builtin_amdgcn_readlane(__float_as_int(v), 32)), r3 = __int_as_float(__builtin_amdgcn_readlane(__float_as_int(v), 48));
    return (r0 + r1) + (r2 + r3);
}
__device__ __forceinline__ float sigmoidf_(float x) { return 1.0f / (1.0f + __expf(-x)); }
#define LAS __attribute__((address_space(3)))
#define GAS __attribute__((address_space(1)))
typedef const GAS float* gfp;
typedef const GAS int* gip;
#define MFMA32(a, b, c) __builtin_amdgcn_mfma_f32_32x32x16_bf16((a), (b), (c), 0, 0, 0)

__device__ const int T5_BUCKET[128] = {0, 1, 2, 3, 4, 5, 6, 7, 8, 9, 10, 11, 12, 13, 14, 15, 16, 16, 16, 17, 17, 18, 18, 18, 19, 19, 19, 20, 20, 20, 20, 21, 21, 21, 21, 22, 22, 22, 22, 22, 23, 23, 23, 23, 23, 23, 24, 24, 24, 24, 24, 24, 25, 25, 25, 25, 25, 25, 25, 26, 26, 26, 26, 26, 26, 26, 26, 27, 27, 27, 27, 27, 27, 27, 27, 27, 27, 28, 28, 28, 28, 28, 28, 28, 28, 28, 28, 29, 29, 29, 29, 29, 29, 29, 29, 29, 29, 29, 29, 30, 30, 30, 30, 30, 30, 30, 30, 30, 30, 30, 30, 30, 30, 31, 31, 31, 31, 31, 31, 31, 31, 31, 31, 31, 31, 31, 31, 31};
__device__ const double ROPE_INV[32] = {1.0, 0.7498942093324559, 0.5623413251903491, 0.4216965034285822, 0.31622776601683794, 0.23713737056616552, 0.1778279410038923, 0.1333521432163324, 0.09999999999999999, 0.07498942093324558, 0.056234132519034905, 0.042169650342858224, 0.03162277660168379, 0.023713737056616554, 0.01778279410038923, 0.013335214321633239, 0.01, 0.007498942093324559, 0.005623413251903491, 0.004216965034285822, 0.0031622776601683794, 0.002371373705661655, 0.0017782794100389228, 0.0013335214321633238, 0.001, 0.0007498942093324559, 0.000562341325190349, 0.00042169650342858224, 0.00031622776601683794, 0.00023713737056616554, 0.0001778279410038923, 0.0001333521432163324};

struct MapId { __device__ int src(int n) const { return n; } __device__ float cs(int) const { return 1.f; } };
struct MapWin {
    __device__ int src(int n) const {
        if (n < 768) return n;
        if (n < 2304) return n + 64;
        if (n < 6400) { const int j = (n - 2304) >> 8, c = (n - 2304) & 255; return c < 128 ? 2368 + 128 * j + c : 2368 + 2048 + 128 * j + (c - 128); }
        const int c = n - 6400; if (c < 32) return 768 + c; if (c >= 128 && c < 160) return 800 + (c - 128); return -1;
    }
    __device__ float cs(int n) const { return (n >= 768 && n < 1792) ? SWA_QSCALE : 1.f; }
};
struct MapWinA {
    __device__ int src(int n) const { if (n < 768) return n; if (n < 2304) return n + 64; const int c = n - 2304; if (c < 32) return 768 + c; if (c >= 128 && c < 160) return 800 + (c - 128); return -1; }
    __device__ float cs(int n) const { return (n >= 768 && n < 1792) ? SWA_QSCALE : 1.f; }
};
struct MapWinG { __device__ int src(int n) const { const int j = n >> 8, c = n & 255; return c < 128 ? 2368 + 128 * j + c : 2368 + 2048 + 128 * j + (c - 128); } __device__ float cs(int) const { return 1.f; } };
struct MapWuq {
    __device__ int src(int n) const {
        if (n < 1024) return (n >> 7) * QKD + (n & 127);
        const int t = (n - 1024) >> 8, c = (n - 1024) & 255, half = c >> 7, hh = (c & 127) >> 5, i = c & 31;
        return (4 * t + hh) * QKD + NOPE + 32 * half + i;
    }
    __device__ float cs(int) const { return MLA_QSCALE; }
};
struct MapGU { __device__ int src(int n) const { const int p = n >> 8, c = n & 255; return c < 128 ? 128 * p + c : 512 + 128 * p + (c - 128); } __device__ float cs(int) const { return 1.f; } };

__device__ __forceinline__ unsigned pack4_fp8_(const f32x4& a) { int p = __float_as_int(a[0]); p = __builtin_amdgcn_cvt_pk_fp8_f32(a[0], a[1], p, false); p = __builtin_amdgcn_cvt_pk_fp8_f32(a[2], a[3], p, true); return (unsigned)p; }
template <class Map>
__device__ __forceinline__ void transpose_item(gfp W, int K, int Nsrc, bf16_t* __restrict__ WT, int Nout, int ldo, int koff, gfp kscale, LAS unsigned char* scr, int item, int lane) {
    const Map map{};
    const int nblk = Nout / 64, kb = item / nblk, nb = item % nblk, k0 = 64 * kb, n0 = 64 * nb;
    const int n4 = lane & 15, kr = lane >> 4, nl = 4 * n4;
    const int sc = map.src(n0 + nl); const float cs = map.cs(n0 + nl);
    f32x4 v[16];
    if (sc >= 0) {
        gfp wp = W + (size_t)(k0 + kr) * Nsrc + sc;
#pragma unroll
        for (int i = 0; i < 16; ++i) v[i] = *(const GAS f32x4*)(wp + (size_t)(4 * i) * Nsrc);
        if (kscale) {
#pragma unroll
            for (int i = 0; i < 16; ++i) v[i] = v[i] * (kscale[k0 + 4 * i + kr] * cs);
        } else if (cs != 1.f) {
#pragma unroll
            for (int i = 0; i < 16; ++i) v[i] = v[i] * cs;
        }
    } else {
#pragma unroll
        for (int i = 0; i < 16; ++i) v[i] = (f32x4){0.f, 0.f, 0.f, 0.f};
    }
#pragma unroll
    for (int i = 0; i < 16; ++i) { const int k = 4 * i + kr; const int cho = (((k >> 3) ^ (n4 & 7)) << 4) + ((k & 7) << 1);
#pragma unroll
        for (int e = 0; e < 4; ++e) *(LAS bf16_t*)(scr + (nl + e) * 128 + cho) = (bf16_t)f2bf(v[i][e]); }
    asm volatile("s_waitcnt lgkmcnt(0)" ::: "memory");
    const int c = lane & 7, nn0 = lane >> 3;
#pragma unroll
    for (int j = 0; j < 8; ++j) { const int nn = 8 * j + nn0; const u32x4 o = *(const LAS u32x4*)(scr + nn * 128 + ((c ^ ((nn >> 2) & 7)) << 4));
        *(u32x4*)(WT + (size_t)(n0 + nn) * ldo + koff + k0 + 8 * c) = o; }
    asm volatile("s_waitcnt lgkmcnt(0)" ::: "memory");
}
template <class Map>
__device__ __forceinline__ void transpose_item8(gfp W, int K, int Nsrc, unsigned char* __restrict__ WT, int Nout, int ldo, int koff, float scale, LAS unsigned char* scr, int item, int lane) {
    const Map map{};
    const int nblk = Nout / 64, kb = item / nblk, nb = item % nblk, k0 = 64 * kb, n0 = 64 * nb;
    const int n4 = lane & 15, kr = lane >> 4, nl = 4 * n4;
    const int sc = map.src(n0 + nl);
    f32x4 v[16];
    if (sc >= 0) { gfp wp = W + (size_t)(k0 + kr) * Nsrc + sc;
#pragma unroll
      for (int i = 0; i < 16; ++i) v[i] = *(const GAS f32x4*)(wp + (size_t)(4 * i) * Nsrc); }
    else {
#pragma unroll
      for (int i = 0; i < 16; ++i) v[i] = (f32x4){0.f, 0.f, 0.f, 0.f}; }
#pragma unroll
    for (int i = 0; i < 16; ++i) { const int k = 4 * i + kr; const int cho = (((k >> 4) ^ (n4 & 3)) << 4) + (k & 15);
        const unsigned p = pack4_fp8_(v[i] * (scale * map.cs(n0 + nl)));
#pragma unroll
        for (int e = 0; e < 4; ++e) *(LAS unsigned char*)(scr + (nl + e) * 64 + cho) = (unsigned char)(p >> (8 * e)); }
    asm volatile("s_waitcnt lgkmcnt(0)" ::: "memory");
    const int c = lane & 3, nn0 = lane >> 2;
#pragma unroll
    for (int j = 0; j < 4; ++j) { const int nn = 16 * j + nn0; const u32x4 o = *(const LAS u32x4*)(scr + nn * 64 + ((c ^ ((nn >> 2) & 3)) << 4));
        *(u32x4*)(WT + (size_t)(n0 + nn) * ldo + koff + k0 + 16 * c) = o; }
    asm volatile("s_waitcnt lgkmcnt(0)" ::: "memory");
}
template <class Map>
__device__ __forceinline__ void t8_load(gfp W, int Nsrc, int Nout, int item, int lane, f32x4 (&v)[16]) {
    const Map map{};
    const int nblk = Nout / 64, kb = item / nblk, nb = item % nblk, k0 = 64 * kb, n0 = 64 * nb;
    gfp wp = W + (size_t)(k0 + 16 * (lane >> 4)) * Nsrc + map.src(n0 + 4 * (lane & 15));
#pragma unroll
    for (int i = 0; i < 16; ++i) v[i] = __builtin_nontemporal_load((const GAS f32x4*)(wp + (size_t)i * Nsrc));
}
__device__ __forceinline__ void t8_proc(const f32x4 (&v)[16], unsigned char* __restrict__ WT, int Nout, int ldo, float scale, LAS unsigned char* scr, int item, int lane) {
    const int nblk = Nout / 64, kb = item / nblk, nb = item % nblk, k0 = 64 * kb, n0 = 64 * nb;
    const int n4 = lane & 15, kr = lane >> 4, nl = 4 * n4;
#pragma unroll
    for (int e = 0; e < 4; ++e) { u32x4 pk;
#pragma unroll
        for (int q = 0; q < 4; ++q) { int p = __float_as_int(v[4 * q][e]); p = __builtin_amdgcn_cvt_pk_fp8_f32(v[4 * q][e] * scale, v[4 * q + 1][e] * scale, p, false); p = __builtin_amdgcn_cvt_pk_fp8_f32(v[4 * q + 2][e] * scale, v[4 * q + 3][e] * scale, p, true); pk[q] = (unsigned)p; }
        *(LAS u32x4*)(scr + (nl + e) * 64 + ((kr ^ (n4 & 3)) << 4)) = pk; }
    asm volatile("s_waitcnt lgkmcnt(0)" ::: "memory");
    const int c = lane & 3, nn0 = lane >> 2;
#pragma unroll
    for (int j = 0; j < 4; ++j) { const int nn = 16 * j + nn0; const u32x4 o = *(const LAS u32x4*)(scr + nn * 64 + ((c ^ ((nn >> 2) & 3)) << 4));
        __builtin_nontemporal_store(o, (u32x4*)(WT + (size_t)(n0 + nn) * ldo + k0 + 16 * c)); }
    asm volatile("s_waitcnt lgkmcnt(0)" ::: "memory");
}
__device__ __forceinline__ int conv_claim(unsigned* ctr, int lane) { int v = 0; if (lane == 0) v = (int)__hip_atomic_fetch_add(ctr, 1u, __ATOMIC_RELAXED, __HIP_MEMORY_SCOPE_AGENT); return v; }
template <class Map>
__device__ __forceinline__ void conv_dynamic(gfp W, gfp Wsh, const int K, const int N, unsigned char* __restrict__ WT, unsigned* ctr, LAS unsigned char* scr, const int lane) {
    const int per = (K / 64) * (N / 64), n = per * (NE + 1); const size_t st = (size_t)K * N;
    f32x4 va[16], vb[16];
    int cur = __builtin_amdgcn_readfirstlane(conv_claim(ctr, lane)), nxt = __builtin_amdgcn_readfirstlane(conv_claim(ctr, lane));
#define CONV_SRC(it_) ((it_) / per < NE ? W + (size_t)((it_) / per) * st : Wsh)
    if (cur < n) t8_load<Map>(CONV_SRC(cur), N, N, cur % per, lane, va);
    while (cur < n) {
        int t = conv_claim(ctr, lane);
        if (nxt < n) t8_load<Map>(CONV_SRC(nxt), N, N, nxt % per, lane, vb);
        t8_proc(va, WT + (size_t)(cur / per) * st, N, K, W8_SCALE, scr, cur % per, lane);
        asm volatile("" : "+v"(t) :: "memory");
        cur = nxt; nxt = __builtin_amdgcn_readfirstlane(t);
        if (cur >= n) break;
        t = conv_claim(ctr, lane);
        if (nxt < n) t8_load<Map>(CONV_SRC(nxt), N, N, nxt % per, lane, va);
        t8_proc(vb, WT + (size_t)(cur / per) * st, N, K, W8_SCALE, scr, cur % per, lane);
        asm volatile("" : "+v"(t) :: "memory");
        cur = nxt; nxt = __builtin_amdgcn_readfirstlane(t);
    }
#undef CONV_SRC
}
template <class Map>
__device__ __forceinline__ void conv_static3(gfp W, const size_t wstride, const int Nsrc, unsigned char* __restrict__ WT, const size_t ostride, const int Nout, const int K, const int Z,
                                             const int gw, const int NGW, LAS unsigned char* scr, const int lane) {
    const int per = (K / 64) * (Nout / 64), n = per * Z; f32x4 va[16], vb[16], vc[16];
#define C3_LD(buf, idx) do { const int i_ = (idx) < n ? (idx) : n - 1; t8_load<Map>(W + (size_t)(i_ / per) * wstride, Nsrc, Nout, i_ % per, lane, buf); } while (0)
#define C3_PR(buf, idx) t8_proc(buf, WT + (size_t)((idx) / per) * ostride, Nout, K, W8_SCALE, scr, (idx) % per, lane)
    int it = gw; if (it >= n) return;
    C3_LD(va, it); C3_LD(vb, it + NGW);
    for (;;) {
        C3_LD(vc, it + 2 * NGW); C3_PR(va, it); if (it + NGW >= n) break;
        C3_LD(va, it + 3 * NGW); C3_PR(vb, it + NGW); if (it + 2 * NGW >= n) break;
        C3_LD(vb, it + 4 * NGW); C3_PR(vc, it + 2 * NGW); it += 3 * NGW; if (it >= n) break;
    }
#undef C3_LD
#undef C3_PR
}
template <class Map>
__device__ __forceinline__ void t8p_load(gfp W, int Nsrc, int Nout, int pair, int half, int lane, f32x4 (&v)[16]) {
    const Map map{};
    const int nblk = Nout / 64, kb = 2 * (pair / nblk) + half, nb = pair % nblk, k0 = 64 * kb, n0 = 64 * nb;
    gfp wp = W + (size_t)(k0 + 16 * (lane >> 4)) * Nsrc + map.src(n0 + 4 * (lane & 15));
#pragma unroll
    for (int i = 0; i < 16; ++i) v[i] = __builtin_nontemporal_load((const GAS f32x4*)(wp + (size_t)i * Nsrc));
}
__device__ __forceinline__ void t8p_proc(const f32x4 (&v)[16], unsigned char* __restrict__ WT, int Nout, int ldo, float scale, LAS unsigned char* scr, int pair, int half, int lane) {
    const int nblk = Nout / 64, nb = pair % nblk, k0 = 128 * (pair / nblk), n0 = 64 * nb;
    const int n4 = lane & 15, kr = lane >> 4, nl = 4 * n4;
#pragma unroll
    for (int e = 0; e < 4; ++e) { u32x4 pk;
#pragma unroll
        for (int q = 0; q < 4; ++q) { int p = __float_as_int(v[4 * q][e]); p = __builtin_amdgcn_cvt_pk_fp8_f32(v[4 * q][e] * scale, v[4 * q + 1][e] * scale, p, false); p = __builtin_amdgcn_cvt_pk_fp8_f32(v[4 * q + 2][e] * scale, v[4 * q + 3][e] * scale, p, true); pk[q] = (unsigned)p; }
        *(LAS u32x4*)(scr + (nl + e) * 128 + (((4 * half + kr) ^ (n4 & 7)) << 4)) = pk; }
    if (half) {
        asm volatile("s_waitcnt lgkmcnt(0)" ::: "memory");
        const int c = lane & 7, nn0 = lane >> 3;
#pragma unroll
        for (int j = 0; j < 8; ++j) { const int nn = 8 * j + nn0; const u32x4 o = *(const LAS u32x4*)(scr + nn * 128 + ((c ^ ((nn >> 2) & 7)) << 4));
            __builtin_nontemporal_store(o, (u32x4*)(WT + (size_t)(n0 + nn) * ldo + k0 + 16 * c)); }
        asm volatile("s_waitcnt lgkmcnt(0)" ::: "memory");
    }
}
template <class Map>
__device__ __forceinline__ void conv_pairs3(gfp W, const size_t wstride, const int Nsrc, unsigned char* __restrict__ WT, const size_t ostride, const int Nout, const int K, const int Z,
                                            const int gw, const int NGW, LAS unsigned char* scr, const int lane) {
    const int perp = (K / 128) * (Nout / 64), np = perp * Z; if (gw >= np) return;
    const int nj = 2 * ((np - gw + NGW - 1) / NGW);
    f32x4 va[16], vb[16], vc[16];
#define CP_LD(buf, j_) do { const int jj_ = (j_) < nj ? (j_) : nj - 1; const int p_ = gw + (jj_ >> 1) * NGW; t8p_load<Map>(W + (size_t)(p_ / perp) * wstride, Nsrc, Nout, p_ % perp, jj_ & 1, lane, buf); } while (0)
#define CP_PR(buf, j_) do { const int p_ = gw + ((j_) >> 1) * NGW; t8p_proc(buf, WT + (size_t)(p_ / perp) * ostride, Nout, K, W8_SCALE, scr, p_ % perp, (j_) & 1, lane); } while (0)
    int j = 0;
    CP_LD(va, 0); CP_LD(vb, 1);
    for (;;) {
        CP_LD(vc, j + 2); CP_PR(va, j); if (j + 1 >= nj) break;
        CP_LD(va, j + 3); CP_PR(vb, j + 1); if (j + 2 >= nj) break;
        CP_LD(vb, j + 4); CP_PR(vc, j + 2); j += 3; if (j >= nj) break;
    }
#undef CP_LD
#undef CP_PR
}
__device__ __forceinline__ void b_router_split(const int vbid, const int vtid, gfp w, bf16_t* __restrict__ hi, bf16_t* __restrict__ lo) {
    const int idx = vbid * 256 + vtid; if (idx >= NE * DM) return;
    const int j = idx & 7, lane = (idx >> 3) & 63, nb = (idx >> 9) & 3, ks = (idx >> 11) & 7, wv = idx >> 14;
    const int e = 16 * nb + (lane & 15), k = 256 * wv + 32 * ks + 8 * (lane >> 4) + j;
    const float v = w[(size_t)k * NE + e]; const unsigned h = f2bf(v); const float r = v - __uint_as_float(h << 16);
    hi[idx] = (bf16_t)h; lo[idx] = (bf16_t)f2bf(r);
}
__device__ __forceinline__ void b_rope_table(const int vbid, const int vtid, gip pos, float* __restrict__ rc, float* __restrict__ rs) {
    const int idx = vbid * 256 + vtid; if (idx >= T * 32) return;
    const int t = idx >> 5, i = idx & 31;
    const double a = (double)pos[t] * ROPE_INV[i];
    const double k = __builtin_rint(a * 0.15915494309189535);
    const double r = __builtin_fma(-k, 6.283185307179586, a) - k * 2.4492935982947064e-16;
    const float rf = (float)r;
    rc[idx] = __cosf(rf); rs[idx] = __sinf(rf);
}

namespace pg8 {
constexpr int BM = 256, BK = 64, HALF = 128, HTB = HALF * BK * 2, STAGE_BYTES = 8 * HTB, NXCD = 8, WGM = 8;
__device__ __forceinline__ int lds_byte(int r, int c) { const int st = (r >> 4) * 2 + (c >> 5), rr = r & 15, cc = c & 31, ob = rr * 64 + cc * 2; return st * 1024 + (ob ^ (((ob >> 9) & 1) << 5)); }
__device__ __forceinline__ void stage_rc(int b, int& R, int& C) { const int st = b / 1024, sb = b % 1024, swz = sb ^ (((sb >> 9) & 1) << 5); R = (st >> 1) * 16 + swz / 64; C = (st & 1) * 32 + (swz % 64) / 2; }
__device__ __forceinline__ int perm32(int rho) { const int n = rho >> 4, i = rho & 15; return 8 * (i >> 2) + 4 * n + (i & 3); }
struct Unit { int pm, pn; size_t boff; };
struct MoeMap { const int* list; const LAS int* tbase; const LAS int* cnt; const LAS unsigned char* tile_e; };
__device__ __forceinline__ int moe_token(const MoeMap& mm, int pm, int r) { const int e = mm.tile_e[pm], idx = (pm - mm.tbase[e]) * 256 + r; if (e == NE) return idx; return idx < mm.cnt[e] ? mm.list[(size_t)e * T + idx] : 0; }
__device__ __forceinline__ int moe_dest(const MoeMap& mm, int pm, int r) { const int e = mm.tile_e[pm], idx = (pm - mm.tbase[e]) * 256 + r; if (e == NE) return idx * 9 + 8; return idx < mm.cnt[e] ? mm.list[(size_t)e * T + idx] : -1; }
struct Gemm { const void* A; const void* Bt; MoeMap mm; int K; int noepi; unsigned sa, sb; };
struct StaticOrder {
    int nM, nN, nwg, G, c, K;
    __device__ void init(int M, int N, int K_, int G_, int c_) { nM = M / BM; nN = N / BM; nwg = nM * nN; G = G_; c = c_; K = K_; }
    __device__ bool next(int i, Unit& u) const {
        const long L = (long)i * G + c; if (L >= nwg) return false;
        int wgid = (int)L; { const int q = nwg / NXCD, r = nwg % NXCD, xcd = wgid % NXCD, off = wgid / NXCD; wgid = (xcd < r ? xcd * (q + 1) : r * (q + 1) + (xcd - r) * q) + off; }
        const int nig = WGM * nN, gid = wgid / nig, fm = gid * WGM, gsz = (nM - fm) < WGM ? (nM - fm) : WGM;
        u.pm = __builtin_amdgcn_readfirstlane(fm + ((wgid % nig) % gsz)); u.pn = __builtin_amdgcn_readfirstlane((wgid % nig) / gsz); u.boff = (size_t)u.pn * BM * K; return true;
    }
};
struct MoeOrder {
    int NT, nN, G, c, K; size_t estride; const LAS unsigned char* tile_e;
    __device__ bool next(int i, Unit& u) const {
        const int x = c & 7, j = c >> 3, per = G >> 3, s = i * per + j, gsz = 8 * nN;
        const int grp = (s / gsz) * 8 + x, idx = s % gsz, pm = grp * 8 + (idx & 7), pn = idx >> 3;
        if (grp * 8 >= NT) return false;
        const int pmc = __builtin_amdgcn_readfirstlane(pm < NT ? pm : NT - 1); u.pn = __builtin_amdgcn_readfirstlane(pn); const int e = __builtin_amdgcn_readfirstlane((int)tile_e[pmc]); u.boff = (size_t)e * estride + (size_t)u.pn * BM * K;
        u.pm = __builtin_amdgcn_readfirstlane(pm >= NT ? -1 - pmc : pmc);
        return true;
    }
};
__device__ __forceinline__ unsigned cvt_pk_bf16(float lo, float hi) { unsigned r; asm volatile("v_cvt_pk_bf16_f32 %0, %1, %2" : "=v"(r) : "v"(lo), "v"(hi)); return r; }
__device__ __forceinline__ u32x4 pack8(const f32x4& a, const f32x4& b) { u32x4 w; w.x = cvt_pk_bf16(a[0], a[1]); w.y = cvt_pk_bf16(a[2], a[3]); w.z = cvt_pk_bf16(b[0], b[1]); w.w = cvt_pk_bf16(b[2], b[3]); return w; }
__device__ __forceinline__ void unpack8(const u32x4& w, f32x4& a, f32x4& b) {
    a[0] = __uint_as_float(w.x << 16); a[1] = __uint_as_float(w.x & 0xffff0000u); a[2] = __uint_as_float(w.y << 16); a[3] = __uint_as_float(w.y & 0xffff0000u);
    b[0] = __uint_as_float(w.z << 16); b[1] = __uint_as_float(w.z & 0xffff0000u); b[2] = __uint_as_float(w.w << 16); b[3] = __uint_as_float(w.w & 0xffff0000u); }

__device__ __forceinline__ const char* uptr(const char* p) { const unsigned long long v = (unsigned long long)p; const unsigned lo = __builtin_amdgcn_readfirstlane((unsigned)v), hi = __builtin_amdgcn_readfirstlane((unsigned)(v >> 32)); return (const char*)(((unsigned long long)hi << 32) | lo); }
template <bool GATHER, int ES, class Epi, class Sched>
__device__ __forceinline__ void gemm_phase(LAS unsigned char* lds, const Gemm g, const Sched& S, const Epi& E) {
    int tid = threadIdx.x; asm volatile("" : "+v"(tid));
    const int wid = __builtin_amdgcn_readfirstlane(tid >> 6), lane = tid & 63, wr = wid >> 2, wc = wid & 3, fr = lane & 15, fq = lane >> 4;
    int Kop = g.K; asm volatile("" : "+s"(Kop));
    const int K = Kop * ES;
    const int nt = K / 128;
    int RA[2]; unsigned voffA[2], voffB[2];
#pragma unroll
    for (int i = 0; i < 2; ++i) { int R, C; stage_rc(tid * 16 + i * 8192, R, C); const int Rb = (R & ~31) + perm32(R & 31); RA[i] = R; voffA[i] = GATHER ? (unsigned)C * 2u : (unsigned)(R * K) + (unsigned)C * 2u;
        const int Rb64 = 64 * (R >> 5) + 16 * ((R & 15) >> 2) + 4 * ((R >> 4) & 1) + (R & 3);
        voffB[i] = (unsigned)((Epi::BMAP ? Rb64 : Rb) * K) + (unsigned)C * 2u; }
    const size_t kstep = (size_t)(BK * 2);
    const size_t hstep = (size_t)HALF * K;
    const size_t tstep = 2 * hstep;
    const size_t hstepB = Epi::BMAP ? (size_t)8 * K : hstep;
    const unsigned ldsw = (unsigned)wid * 1024u;
    const int aoff = lds_byte(wr * 64 + fr, fq * 8), boff = lds_byte(wc * 32 + fr, fq * 8);
#define PG8_SA(b, h) (((b) * 2 + (h)) * HTB)
#define PG8_SB(b, h) ((4 + (b) * 2 + (h)) * HTB)
#define PG8_STAGEB(bufoff, gbase) do { _Pragma("unroll") for (int _i = 0; _i < 2; ++_i) \
        __builtin_amdgcn_global_load_lds((const unsigned*)((const char*)(gbase) + voffB[_i]), (LAS unsigned*)(lds + (bufoff) + ldsw + _i * 8192), 16, 0, 0); } while (0)
#define PG8_STAGEA(bufoff, gbase, v0, v1) do { \
        __builtin_amdgcn_global_load_lds((const unsigned*)((const char*)(gbase) + (v0)), (LAS unsigned*)(lds + (bufoff) + ldsw), 16, 0, 0); \
        __builtin_amdgcn_global_load_lds((const unsigned*)((const char*)(gbase) + (v1)), (LAS unsigned*)(lds + (bufoff) + ldsw + 8192), 16, 0, 0); } while (0)
    typedef int v8i_ __attribute__((ext_vector_type(8)));
#define PG8_LDA(dst, b, h) do { if constexpr (ES == 2) { _Pragma("unroll") for (int m = 0; m < 4; ++m) _Pragma("unroll") for (int k = 0; k < 2; ++k) dst[m][k] = *(const LAS bf16x8*)(lds + PG8_SA(b, h) + aoff + m * 2048 + k * 1024); } \
        else { typedef int v4i_ __attribute__((ext_vector_type(4))); _Pragma("unroll") for (int m = 0; m < 4; ++m) { const v4i_ lo_ = *(const LAS v4i_*)(lds + PG8_SA(b, h) + aoff + m * 2048), hi_ = *(const LAS v4i_*)(lds + PG8_SA(b, h) + aoff + m * 2048 + 1024); \
            dst##8[m] = __builtin_shufflevector(lo_, hi_, 0, 1, 2, 3, 4, 5, 6, 7); } } } while (0)
#define PG8_LDB(dst, b, h) do { if constexpr (ES == 2) { _Pragma("unroll") for (int n = 0; n < 2; ++n) _Pragma("unroll") for (int k = 0; k < 2; ++k) dst[n][k] = *(const LAS bf16x8*)(lds + PG8_SB(b, h) + boff + n * 2048 + k * 1024); } \
        else { typedef int v4i_ __attribute__((ext_vector_type(4))); _Pragma("unroll") for (int n = 0; n < 2; ++n) { const v4i_ lo_ = *(const LAS v4i_*)(lds + PG8_SB(b, h) + boff + n * 2048), hi_ = *(const LAS v4i_*)(lds + PG8_SB(b, h) + boff + n * 2048 + 1024); \
            dst##8[n] = __builtin_shufflevector(lo_, hi_, 0, 1, 2, 3, 4, 5, 6, 7); } } } while (0)
#ifdef GEMM_PROBES
#define PG8_NOMMA (g.noepi & 4)
#else
#define PG8_NOMMA false
#endif
#define PG8_MMA(ai, bj, At, Bt) do { if (PG8_NOMMA) break; __builtin_amdgcn_s_setprio(1); _Pragma("unroll") for (int m = 0; m < 4; ++m) _Pragma("unroll") for (int n = 0; n < 2; ++n) { \
        if constexpr (ES == 2) { _Pragma("unroll") for (int k = 0; k < 2; ++k) acc[ai][bj][m][n] = __builtin_amdgcn_mfma_f32_16x16x32_bf16(Bt[n][k], At[m][k], acc[ai][bj][m][n], 0, 0, 0); } \
        else asm volatile("v_mfma_scale_f32_16x16x128_f8f6f4 %0, %1, %2, %0, %3, %4 op_sel_hi:[0,0,0]" : "+v"(acc[ai][bj][m][n]) : "v"(Bt##8[n]), "v"(At##8[m]), "v"(vsb), "v"(vsa)); } \
        __builtin_amdgcn_s_setprio(0); } while (0)
#define PG8_WAIT_V(n) asm volatile("s_waitcnt vmcnt(" #n ")" ::: "memory")
#define PG8_WAIT_L(n) asm volatile("s_waitcnt lgkmcnt(" #n ")" ::: "memory")
    static_assert(Epi::RELAX == 0 || Epi::RELAX == 8, "PG8_WAIT_R encodes 8 + RELAX as an immediate");
#define PG8_WAIT_R do { if (Epi::RELAX > 0 && fst) asm volatile("s_waitcnt vmcnt(16)" ::: "memory"); else asm volatile("s_waitcnt vmcnt(8)" ::: "memory"); } while (0)
#define PG8_BAR __builtin_amdgcn_s_barrier()
#define PG8_SCHED __builtin_amdgcn_sched_barrier(0)
#define PG8_AOFF_RAW(raw, mk, sb, u_) do { if (GATHER) { const int pm_ = (u_).pm < 0 ? -1 - (u_).pm : (u_).pm; const int e_ = __builtin_amdgcn_readfirstlane((int)g.mm.tile_e[pm_]); \
        const int base_ = (pm_ - __builtin_amdgcn_readfirstlane(g.mm.tbase[e_])) * 256; const int es_ = e_ == NE ? 0 : e_, c_ = e_ == NE ? 0 : __builtin_amdgcn_readfirstlane(g.mm.cnt[es_]); \
        const int* lp_ = g.mm.list + (size_t)es_ * T; int m_ = 0; \
        _Pragma("unroll") for (int h_ = 0; h_ < 2; ++h_) _Pragma("unroll") for (int i_ = 0; i_ < 2; ++i_) { const int idx_ = base_ + h_ * HALF + RA[i_]; raw[h_][i_] = (unsigned)lp_[idx_ < c_ ? idx_ : 0]; m_ |= (idx_ < c_ ? 1 : 0) << (2 * h_ + i_); } \
        mk = e_ == NE ? -1 : m_; sb = base_; } } while (0)
#define PG8_AOFF_FIN(dst, raw, mk, sb) do { if (GATHER) { _Pragma("unroll") for (int h_ = 0; h_ < 2; ++h_) _Pragma("unroll") for (int i_ = 0; i_ < 2; ++i_) \
        dst[h_][i_] = ((mk) < 0 ? (unsigned)((sb) + h_ * HALF + RA[i_]) : ((((mk) >> (2 * h_ + i_)) & 1) ? raw[h_][i_] : 0u)) * (unsigned)K + voffA[i_]; } } while (0)
#define PG8_AOFF(dst, u_) do { unsigned raw_[2][2] = {{0u, 0u}, {0u, 0u}}; int mk_ = 0, sb_ = 0; PG8_AOFF_RAW(raw_, mk_, sb_, u_); PG8_AOFF_FIN(dst, raw_, mk_, sb_); } while (0)
#define PG8_PMROW(u_) ((size_t)((u_).pm < 0 ? -1 - (u_).pm : (u_).pm))
    Unit cur, nxt; int ui = 0;
    bool rel = false;
    if (!S.next(0, cur)) return;
#ifdef GEMM_PROBES
    if (g.noepi & 2) { cur.pm = 0; cur.pn = 0; cur.boff = 0; }
#endif
    f32x4 acc[2][2][4][2];
#pragma unroll
    for (int a = 0; a < 2; ++a)
#pragma unroll
        for (int b = 0; b < 2; ++b)
#pragma unroll
            for (int m = 0; m < 4; ++m)
#pragma unroll
                for (int n = 0; n < 2; ++n) acc[a][b][m][n] = (f32x4){0.f, 0.f, 0.f, 0.f};
    bf16x8 At[4][2], B0[2][2], B1[2][2];
    v8i_ At8[4], B08[2], B18[2];
    const unsigned vsa = g.sa, vsb = g.sb; (void)vsa; (void)vsb;
    unsigned vc[2][2], vn[2][2], vnn[2][2];
    PG8_AOFF(vc, cur);
    if (GATHER) { Unit n1_; if (S.next(1, n1_)) { PG8_AOFF(vn, n1_); } else { _Pragma("unroll") for (int h_ = 0; h_ < 2; ++h_) _Pragma("unroll") for (int i_ = 0; i_ < 2; ++i_) vn[h_][i_] = vc[h_][i_]; } }
    const char* cA = uptr(GATHER ? (const char*)g.A : (const char*)g.A + PG8_PMROW(cur) * tstep);
    const char* cB = uptr((const char*)g.Bt + cur.boff * ES);
#define VA(X, h, i) (GATHER ? X[h][i] : voffA[i])
#define HS(h) (GATHER ? (size_t)0 : (size_t)(h) * hstep)
    PG8_STAGEB(PG8_SB(0, 0), cB); PG8_STAGEB(PG8_SB(0, 1), cB + hstepB); PG8_STAGEA(PG8_SA(0, 0), cA, VA(vc, 0, 0), VA(vc, 0, 1)); PG8_STAGEA(PG8_SA(0, 1), cA + HS(1), VA(vc, 1, 0), VA(vc, 1, 1));
    if (wr == 1) PG8_BAR;
    PG8_WAIT_V(2); PG8_BAR;
    PG8_STAGEB(PG8_SB(1, 0), cB + kstep); PG8_STAGEA(PG8_SA(1, 0), cA + kstep, VA(vc, 0, 0), VA(vc, 0, 1)); PG8_STAGEB(PG8_SB(1, 1), cB + hstepB + kstep);
    PG8_WAIT_V(6); PG8_BAR;
    for (;;) {
        const bool has_next = S.next(ui + 1, nxt);
#ifdef GEMM_PROBES
        if (g.noepi & 2) { nxt.pm = 0; nxt.pn = 0; nxt.boff = 0; }
#endif
        const char* nA = uptr(GATHER ? cA : (has_next ? (const char*)g.A + PG8_PMROW(nxt) * tstep : cA));
        const char* nB = uptr(has_next ? (const char*)g.Bt + nxt.boff * ES : cB);
        for (int part = 0; part < (Epi::MID ? 2 : 1); ++part) {
        if (Epi::MID && part == 1) { if constexpr (ES == 1) asm volatile("s_nop 15\n\ts_nop 15" ::: "memory"); E.mid(acc, cur, wr, wc, fr, fq); if constexpr (ES == 1) asm volatile("s_nop 7" ::: "memory"); }
        const int t_lo = Epi::MID ? part * (nt >> 1) : 0, t_hi = Epi::MID ? (part + 1) * (nt >> 1) : nt;
        for (int t = t_lo; t < t_hi; t += 2) {
            const bool last = (t == nt - 2);
            const bool fst = Epi::RELAX > 0 && rel && part == 0 && t == 0;
            const char* a1 = cA + (size_t)(t + 1) * kstep;
            const char* a2 = last ? nA : cA + (size_t)(t + 2) * kstep; const char* b2 = last ? nB : cB + (size_t)(t + 2) * kstep;
            const char* a3 = a2 + kstep; const char* b3 = b2 + kstep;
            unsigned w00 = 0, w01 = 0, w10 = 0, w11 = 0;
            if (GATHER) { w00 = last ? vn[0][0] : vc[0][0]; w01 = last ? vn[0][1] : vc[0][1]; w10 = last ? vn[1][0] : vc[1][0]; w11 = last ? vn[1][1] : vc[1][1]; }
#define WA(h, i, w) (GATHER ? (w) : voffA[i])
            PG8_LDB(B0, 0, 0); PG8_LDB(B1, 0, 1); PG8_SCHED; PG8_LDA(At, 0, 0); PG8_STAGEA(PG8_SA(1, 1), a1 + HS(1), VA(vc, 1, 0), VA(vc, 1, 1));
            PG8_WAIT_R; PG8_WAIT_L(0); PG8_BAR; PG8_MMA(0, 0, At, B0); PG8_MMA(0, 1, At, B1); PG8_BAR; PG8_SCHED;
            PG8_LDA(At, 0, 1); PG8_STAGEB(PG8_SB(0, 0), b2); PG8_STAGEB(PG8_SB(0, 1), b2 + hstepB); PG8_STAGEA(PG8_SA(0, 0), a2, WA(0, 0, w00), WA(0, 1, w01));
            PG8_WAIT_R; PG8_WAIT_L(0); PG8_BAR; PG8_MMA(1, 0, At, B0); PG8_MMA(1, 1, At, B1); PG8_BAR; PG8_SCHED;
            PG8_LDB(B0, 1, 0); PG8_LDB(B1, 1, 1); PG8_SCHED; PG8_LDA(At, 1, 0); PG8_STAGEA(PG8_SA(0, 1), a2 + HS(1), WA(1, 0, w10), WA(1, 1, w11));
            PG8_WAIT_V(8); PG8_WAIT_L(0); PG8_BAR; PG8_MMA(0, 0, At, B0); PG8_MMA(0, 1, At, B1); PG8_BAR; PG8_SCHED;
            PG8_LDA(At, 1, 1); PG8_STAGEB(PG8_SB(1, 0), b3); PG8_STAGEB(PG8_SB(1, 1), b3 + hstepB); PG8_STAGEA(PG8_SA(1, 0), a3, WA(0, 0, w00), WA(0, 1, w01));
            PG8_WAIT_V(8); PG8_WAIT_L(0); PG8_BAR; PG8_MMA(1, 0, At, B0); PG8_MMA(1, 1, At, B1); PG8_BAR; PG8_SCHED;
#undef WA
        }
        }
        unsigned vnr_[2][2] = {{0u, 0u}, {0u, 0u}}; int mkn_ = 0, sbn_ = 0; bool hnn_ = false;
        if (GATHER) { Unit nn_; hnn_ = S.next(ui + 2, nn_); if (hnn_) { PG8_AOFF_RAW(vnr_, mkn_, sbn_, nn_); } }
        if (Epi::ALIGN) { if (wr == 0) PG8_BAR; }
        if constexpr (ES == 1) asm volatile("s_nop 15\n\ts_nop 15" ::: "memory");
        rel = cur.pm >= 0 && !(g.noepi & 1);
        if (rel) E(acc, cur, wr, wc, fr, fq);
        if (GATHER) { if (hnn_) { PG8_AOFF_FIN(vnn, vnr_, mkn_, sbn_); } else { _Pragma("unroll") for (int h_ = 0; h_ < 2; ++h_) _Pragma("unroll") for (int i_ = 0; i_ < 2; ++i_) vnn[h_][i_] = vn[h_][i_]; } }
        if constexpr (Epi::SPLIT) { if (rel) E.store(acc, cur, wr, wc, fr, fq); }
        if (!has_next) break;
#pragma unroll
        for (int a = 0; a < 2; ++a)
#pragma unroll
            for (int b = 0; b < 2; ++b)
#pragma unroll
                for (int m = 0; m < 4; ++m)
#pragma unroll
                    for (int n = 0; n < 2; ++n) acc[a][b][m][n] = (f32x4){0.f, 0.f, 0.f, 0.f};
        cur = nxt; cA = nA; cB = nB; ++ui;
        if (GATHER) {
#pragma unroll
            for (int h_ = 0; h_ < 2; ++h_)
#pragma unroll
                for (int i_ = 0; i_ < 2; ++i_) { vc[h_][i_] = vn[h_][i_]; vn[h_][i_] = vnn[h_][i_]; } }
        if (Epi::ALIGN) { if (wr == 1) PG8_BAR; }
    }
    PG8_WAIT_V(0);
    if (!Epi::ALIGN) { if (wr == 0) PG8_BAR; }
    PG8_BAR;
#undef VA
#undef HS
#undef PG8_PMROW
#undef PG8_SA
#undef PG8_SB
#undef PG8_STAGEA
#undef PG8_STAGEB
#undef PG8_LDA
#undef PG8_LDB
#undef PG8_MMA
#undef PG8_WAIT_V
#undef PG8_WAIT_L
#undef PG8_BAR
#undef PG8_SCHED
#undef PG8_AOFF
}

__device__ __forceinline__ unsigned pack4_fp8(const f32x4& a) { int p = __float_as_int(a[0]); p = __builtin_amdgcn_cvt_pk_fp8_f32(a[0], a[1], p, false); p = __builtin_amdgcn_cvt_pk_fp8_f32(a[2], a[3], p, true); return (unsigned)p; }
#define EPI_ROWS1(...) _Pragma("unroll") for (int ai = 0; ai < 2; ++ai) _Pragma("unroll") for (int m = 0; m < 4; ++m) { const int row = rowb + ai * HALF + m * 16; __VA_ARGS__ asm volatile("" ::: "memory"); }
#define EPI_ROWS(...) _Pragma("unroll") for (int ai = 0; ai < 2; ++ai) _Pragma("unroll") for (int m = 0; m < 4; ++m) { const int row = rowb + ai * HALF + m * 16; __VA_ARGS__ if (m & 1) asm volatile("" ::: "memory"); }
struct FProj {
    static constexpr bool SPLIT = false; static constexpr int RELAX = 0; static constexpr bool MID = false; static constexpr int BMAP = 0; static constexpr bool ALIGN = true;
    bf16_t *CQ, *CKV, *QS, *KS, *VS, *KR, *RT, *G1; gfp bgate; const float *rc, *rs; float* ssq; int mode;
    __device__ __forceinline__ void mid(f32x4 (&)[2][2][4][2], const Unit&, int, int, int, int) const {}
    __device__ __forceinline__ void operator()(const f32x4 (&acc)[2][2][4][2], const Unit& u, int wr, int wc, int fr, int fq) const {
        const int pn = mode == 0 ? u.pn : (mode == 1 ? (u.pn < 9 ? u.pn : 25) : u.pn + 9), c8 = wc * 32 + 8 * fq, rowb = u.pm * BM + wr * 64 + fr;
        if (pn < 9) {
            bf16_t* base; int ld, colt;
            if (pn < 2) { base = CQ; ld = 512; colt = pn * 256; } else if (pn == 2) { base = CKV; ld = 256; colt = 0; } else if (pn < 7) { base = QS; ld = 1024; colt = (pn - 3) * 256; }
            else if (pn == 7) { base = KS; ld = 256; colt = 0; } else { base = VS; ld = 256; colt = 0; }
            EPI_ROWS(
                bf16_t* rp = base + (size_t)row * ld + colt + c8; float s = 0.f;
                _Pragma("unroll") for (int bj = 0; bj < 2; ++bj) { const f32x4 a = acc[ai][bj][m][0], b = acc[ai][bj][m][1]; *(u32x4*)(rp + bj * HALF) = pack8(a, b);
                    s += (a[0] * a[0] + a[1] * a[1]) + (a[2] * a[2] + a[3] * a[3]) + (b[0] * b[0] + b[1] * b[1]) + (b[2] * b[2] + b[3] * b[3]); }
                if (pn < 3) { s += __shfl_xor(s, 16); s += __shfl_xor(s, 32); if (fq == 0) ssq[(size_t)row * 12 + pn * 4 + wc] = s; }
            )
        } else if (pn < 25) {
            const int gcol = (pn - 9) * 128 + c8;
            const f32x4 b00 = *(const GAS f32x4*)(bgate + gcol) * -1.44269504f, b01 = *(const GAS f32x4*)(bgate + gcol + 4) * -1.44269504f, b10 = *(const GAS f32x4*)(bgate + DM + gcol) * -1.44269504f, b11 = *(const GAS f32x4*)(bgate + DM + gcol + 4) * -1.44269504f;
            EPI_ROWS(
                f32x4 rt[2], gg[2];
                _Pragma("unroll") for (int n = 0; n < 2; ++n) { const f32x4 nb0 = n ? b01 : b00, nb1 = n ? b11 : b10;
                    _Pragma("unroll") for (int j = 0; j < 4; ++j) { const float e0 = __builtin_amdgcn_exp2f(__builtin_fmaf(acc[ai][0][m][n][j], -1.44269504f, nb0[j])), e1 = __builtin_amdgcn_exp2f(fminf(__builtin_fmaf(acc[ai][1][m][n][j], -1.44269504f, nb1[j]), 40.f));
                        const float u0 = __builtin_fmaf(e0, 1.0f / G18_SCALE, 1.0f / G18_SCALE), u1 = __builtin_fmaf(e1, 1.0f / G18_SCALE, 1.0f / G18_SCALE);
                        gg[n][j] = __builtin_amdgcn_rcpf(u1); rt[n][j] = u1 * __builtin_amdgcn_rcpf(u0); } }
                if (GATE8) { u32x2 pr, pg; pr.x = pack4_fp8(rt[0]); pr.y = pack4_fp8(rt[1]); pg.x = pack4_fp8(gg[0]); pg.y = pack4_fp8(gg[1]);
                    *(u32x2*)((unsigned char*)RT + (size_t)row * DM + gcol) = pr; *(u32x2*)((unsigned char*)G1 + (size_t)row * DM + gcol) = pg; }
                else { *(u32x4*)(RT + (size_t)row * DM + gcol) = pack8(rt[0], rt[1]); *(u32x4*)(G1 + (size_t)row * DM + gcol) = pack8(gg[0] * (1.0f / G18_SCALE), gg[1] * (1.0f / G18_SCALE)); }
            )
        } else if (wc == 0) {
            EPI_ROWS(
                f32x4 o1[2], o2[2];
                _Pragma("unroll") for (int n = 0; n < 2; ++n) { const f32x4 cs = *(const f32x4*)(rc + (size_t)row * 32 + 8 * fq + 4 * n), sn = *(const f32x4*)(rs + (size_t)row * 32 + 8 * fq + 4 * n);
                    const f32x4 x1 = acc[ai][0][m][n], x2 = acc[ai][1][m][n]; o1[n] = x1 * cs - x2 * sn; o2[n] = x1 * sn + x2 * cs; }
                *(u32x4*)(KR + (size_t)row * 64 + 8 * fq) = pack8(o1[0], o1[1]); *(u32x4*)(KR + (size_t)row * 64 + 32 + 8 * fq) = pack8(o2[0], o2[1]);
            )
        }
    }
};
struct FQ {
    static constexpr bool SPLIT = false; static constexpr int RELAX = 0; static constexpr bool MID = false; static constexpr int BMAP = 0; static constexpr bool ALIGN = true;
    bf16_t* Q; const float* ssq; const float *rc, *rs;
    __device__ __forceinline__ void mid(f32x4 (&)[2][2][4][2], const Unit&, int, int, int, int) const {}
    __device__ __forceinline__ void operator()(const f32x4 (&acc)[2][2][4][2], const Unit& u, int wr, int wc, int fr, int fq) const {
        const int pn = u.pn, c8 = wc * 32 + 8 * fq, rowb = u.pm * BM + wr * 64 + fr;
#pragma unroll
        for (int ai = 0; ai < 2; ++ai) {
            float scl[4];
#pragma unroll
            for (int m = 0; m < 4; ++m) { const size_t row = (size_t)(rowb + ai * HALF + m * 16);
                const f32x4 s0 = *(const f32x4*)(ssq + row * 12), s1 = *(const f32x4*)(ssq + row * 12 + 4);
                scl[m] = 1.0f / sqrtf((((s0[0] + s0[1]) + (s0[2] + s0[3])) + ((s1[0] + s1[1]) + (s1[2] + s1[3]))) * (1.0f / QR) + RMS_EPS); }
            asm volatile("" ::: "memory");
#pragma unroll
            for (int m = 0; m < 4; ++m) { const int row = rowb + ai * HALF + m * 16; const float sc = scl[m];
                bf16_t* q = Q + (size_t)row * (MH * QKD);
                if (pn < 4) { _Pragma("unroll") for (int bj = 0; bj < 2; ++bj) *(u32x4*)(q + (2 * pn + bj) * QKD + c8) = pack8(acc[ai][bj][m][0] * sc, acc[ai][bj][m][1] * sc); }
                else { const int head = 4 * (pn - 4) + wc; f32x4 o1[2], o2[2];
                    _Pragma("unroll") for (int n = 0; n < 2; ++n) { const f32x4 cs = *(const f32x4*)(rc + (size_t)row * 32 + 8 * fq + 4 * n), sn = *(const f32x4*)(rs + (size_t)row * 32 + 8 * fq + 4 * n);
                        const f32x4 x1 = acc[ai][0][m][n] * sc, x2 = acc[ai][1][m][n] * sc; o1[n] = x1 * cs - x2 * sn; o2[n] = x1 * sn + x2 * cs; }
                    *(u32x4*)(q + head * QKD + NOPE + 8 * fq) = pack8(o1[0], o1[1]); *(u32x4*)(q + head * QKD + NOPE + 32 + 8 * fq) = pack8(o2[0], o2[1]); }
                if (m & 1) asm volatile("" ::: "memory"); }
        }
    }
};
struct FKV {
    static constexpr bool SPLIT = false; static constexpr int RELAX = 0; static constexpr bool MID = false; static constexpr int BMAP = 0; static constexpr bool ALIGN = true;
    bf16_t *KN, *VM; const float* ssq;
    __device__ __forceinline__ void mid(f32x4 (&)[2][2][4][2], const Unit&, int, int, int, int) const {}
    __device__ __forceinline__ void operator()(const f32x4 (&acc)[2][2][4][2], const Unit& u, int wr, int wc, int fr, int fq) const {
        const int pn = u.pn, c8 = wc * 32 + 8 * fq, rowb = u.pm * BM + wr * 64 + fr;
        bf16_t* base = (pn < 4 ? KN : VM) + (pn & 3) * 256 + c8;
        float scl[2][4];
        EPI_ROWS( const f32x4 s0 = *(const f32x4*)(ssq + (size_t)row * 12 + 8); scl[ai][m] = 1.0f / sqrtf(((s0[0] + s0[1]) + (s0[2] + s0[3])) * (1.0f / KVR) + RMS_EPS); )
        EPI_ROWS(
            const float sc = scl[ai][m];
            _Pragma("unroll") for (int bj = 0; bj < 2; ++bj) *(u32x4*)(base + (size_t)row * 1024 + bj * HALF) = pack8(acc[ai][bj][m][0] * sc, acc[ai][bj][m][1] * sc);
        )
    }
};
__device__ __forceinline__ void unpack8_fp8(const u32x2& w, f32x4& a, f32x4& b) { typedef float f32x2_ __attribute__((ext_vector_type(2)));
    const f32x2_ a0 = __builtin_amdgcn_cvt_pk_f32_fp8((int)w.x, false), a1 = __builtin_amdgcn_cvt_pk_f32_fp8((int)w.x, true), b0 = __builtin_amdgcn_cvt_pk_f32_fp8((int)w.y, false), b1 = __builtin_amdgcn_cvt_pk_f32_fp8((int)w.y, true);
    a = (f32x4){a0[0], a0[1], a1[0], a1[1]}; b = (f32x4){b0[0], b0[1], b1[0], b1[1]}; }
struct FMerge {
    static constexpr bool SPLIT = false; static constexpr int RELAX = 0; static constexpr bool MID = true; static constexpr int BMAP = 0; static constexpr bool ALIGN = true;
    const bf16_t *RT, *G1; bf16_t* MG;
    __device__ __forceinline__ void mid(f32x4 (&acc)[2][2][4][2], const Unit& u, int, int, int, int) const {
        int t_ = threadIdx.x; asm volatile("" : "+v"(t_)); const int wr = t_ >> 8, wc = (t_ >> 6) & 3, fr = t_ & 15, fq = (t_ >> 4) & 3;
        const int rowb = u.pm * BM + wr * 64 + fr, col = u.pn * BM + wc * 32 + 8 * fq;
        if (GATE8) {
            u32x2 w[2][4][2];
#pragma unroll
            for (int ai = 0; ai < 2; ++ai)
#pragma unroll
                for (int m = 0; m < 4; ++m)
#pragma unroll
                    for (int bj = 0; bj < 2; ++bj) w[ai][m][bj] = *(const u32x2*)((const unsigned char*)RT + (size_t)(rowb + ai * HALF + m * 16) * DM + col + bj * HALF);
#pragma unroll
            for (int ai = 0; ai < 2; ++ai)
#pragma unroll
                for (int m = 0; m < 4; ++m)
#pragma unroll
                    for (int bj = 0; bj < 2; ++bj) { f32x4 a, b; unpack8_fp8(w[ai][m][bj], a, b); acc[ai][bj][m][0] *= a; acc[ai][bj][m][1] *= b; }
        } else {
        u32x4 w[2][4][2];
#pragma unroll
        for (int ai = 0; ai < 2; ++ai)
#pragma unroll
            for (int m = 0; m < 4; ++m)
#pragma unroll
                for (int bj = 0; bj < 2; ++bj) w[ai][m][bj] = *(const u32x4*)(RT + (size_t)(rowb + ai * HALF + m * 16) * DM + col + bj * HALF);
#pragma unroll
        for (int ai = 0; ai < 2; ++ai)
#pragma unroll
            for (int m = 0; m < 4; ++m)
#pragma unroll
                for (int bj = 0; bj < 2; ++bj) { f32x4 a, b; unpack8(w[ai][m][bj], a, b); acc[ai][bj][m][0] *= a; acc[ai][bj][m][1] *= b; }
        }
    }
    __device__ __forceinline__ void operator()(const f32x4 (&acc)[2][2][4][2], const Unit& u, int, int, int, int) const {
        int t_ = threadIdx.x; asm volatile("" : "+v"(t_)); const int wr = t_ >> 8, wc = (t_ >> 6) & 3, fr = t_ & 15, fq = (t_ >> 4) & 3;
        const int rowb = u.pm * BM + wr * 64 + fr, col = u.pn * BM + wc * 32 + 8 * fq;
        if constexpr (GATE8 && MIX_FP8 && G18_SCALE == MG8_SCALE) {
            u32x2 w8[2][4][2];
#pragma unroll
            for (int ai = 0; ai < 2; ++ai)
#pragma unroll
                for (int m = 0; m < 4; ++m)
#pragma unroll
                    for (int bj = 0; bj < 2; ++bj) w8[ai][m][bj] = *(const u32x2*)((const unsigned char*)G1 + (size_t)(rowb + ai * HALF + m * 16) * DM + col + bj * HALF);
#pragma unroll
            for (int ai = 0; ai < 2; ++ai)
#pragma unroll
                for (int m = 0; m < 4; ++m)
#pragma unroll
                    for (int bj = 0; bj < 2; ++bj) { f32x4 a, b; unpack8_fp8(w8[ai][m][bj], a, b); u32x2 pk; pk.x = pack4_fp8(acc[ai][bj][m][0] * a); pk.y = pack4_fp8(acc[ai][bj][m][1] * b);
                        *(u32x2*)((unsigned char*)MG + (size_t)(rowb + ai * HALF + m * 16) * DM + col + bj * HALF) = pk; }
            return;
        }
#pragma unroll
        for (int ai = 0; ai < 2; ++ai)
#pragma unroll
            for (int mp = 0; mp < 2; ++mp) {
                u32x4 wv[2][2]; u32x2 wv8[2][2];
#pragma unroll
                for (int m2 = 0; m2 < 2; ++m2)
#pragma unroll
                    for (int bj = 0; bj < 2; ++bj) { const size_t o = (size_t)(rowb + ai * HALF + (2 * mp + m2) * 16) * DM + col + bj * HALF;
                        if (GATE8) wv8[m2][bj] = *(const u32x2*)((const unsigned char*)G1 + o); else wv[m2][bj] = *(const u32x4*)(G1 + o); }
                asm volatile("" ::: "memory");
#pragma unroll
                for (int m2 = 0; m2 < 2; ++m2)
#pragma unroll
                    for (int bj = 0; bj < 2; ++bj) { const int m = 2 * mp + m2; f32x4 a, b; if (GATE8) { unpack8_fp8(wv8[m2][bj], a, b); if (!(MIX_FP8 && G18_SCALE == MG8_SCALE)) { a = a * (1.0f / G18_SCALE); b = b * (1.0f / G18_SCALE); } } else unpack8(wv[m2][bj], a, b);
                        if (MIX_FP8 && GATE8 && G18_SCALE == MG8_SCALE) { u32x2 pk; pk.x = pack4_fp8(acc[ai][bj][m][0] * a); pk.y = pack4_fp8(acc[ai][bj][m][1] * b);     *(u32x2*)((unsigned char*)MG + (size_t)(rowb + ai * HALF + m * 16) * DM + col + bj * HALF) = pk; }
                        else if (MIX_FP8) { u32x2 pk; pk.x = pack4_fp8(acc[ai][bj][m][0] * a * MG8_SCALE); pk.y = pack4_fp8(acc[ai][bj][m][1] * b * MG8_SCALE); *(u32x2*)((unsigned char*)MG + (size_t)(rowb + ai * HALF + m * 16) * DM + col + bj * HALF) = pk; }
                        else *(u32x4*)(MG + (size_t)(rowb + ai * HALF + m * 16) * DM + col + bj * HALF) = pack8(acc[ai][bj][m][0] * a, acc[ai][bj][m][1] * b); }
                asm volatile("" ::: "memory");
            }
    }
};
struct FOut {
    static constexpr bool SPLIT = false; static constexpr int RELAX = 0; static constexpr bool MID = false; static constexpr int BMAP = 0; static constexpr bool ALIGN = true;
    gfp x; bf16_t* hpre;
    __device__ __forceinline__ void mid(f32x4 (&)[2][2][4][2], const Unit&, int, int, int, int) const {}
    __device__ __forceinline__ void operator()(const f32x4 (&acc)[2][2][4][2], const Unit& u, int wr, int wc, int fr, int fq) const {
        const int rowb = u.pm * BM + wr * 64 + fr, col = u.pn * BM + wc * 32 + 8 * fq;
        f32x4 xa[2][2][2], xb[2][2][2];
#define FO_OFF(gq, m2, bj, n) ((size_t)(rowb + ((gq) >> 1) * HALF + (2 * ((gq) & 1) + (m2)) * 16) * DM + col + (bj) * HALF + 4 * (n))
#define FO_LOAD(S_, gq) _Pragma("unroll") for (int m2 = 0; m2 < 2; ++m2) _Pragma("unroll") for (int bj = 0; bj < 2; ++bj) _Pragma("unroll") for (int n = 0; n < 2; ++n) S_[m2][bj][n] = *(const GAS f32x4*)(x + FO_OFF(gq, m2, bj, n));
#define FO_STORE(S_, gq) _Pragma("unroll") for (int m2 = 0; m2 < 2; ++m2) _Pragma("unroll") for (int bj = 0; bj < 2; ++bj) \
            *(u32x4*)(hpre + FO_OFF(gq, m2, bj, 0)) = pack8(S_[m2][bj][0] * ALPHA + acc[(gq) >> 1][bj][2 * ((gq) & 1) + m2][0], S_[m2][bj][1] * ALPHA + acc[(gq) >> 1][bj][2 * ((gq) & 1) + m2][1]);
        FO_LOAD(xa, 0) FO_LOAD(xb, 1) asm volatile("" ::: "memory");
        FO_STORE(xa, 0) FO_LOAD(xa, 2) asm volatile("" ::: "memory");
        FO_STORE(xb, 1) FO_LOAD(xb, 3) asm volatile("" ::: "memory");
        FO_STORE(xa, 2) asm volatile("" ::: "memory");
        FO_STORE(xb, 3)
#undef FO_OFF
#undef FO_LOAD
#undef FO_STORE
    }
};
struct FGU {
    static constexpr bool SPLIT = false; static constexpr int RELAX = 0; static constexpr bool MID = false; static constexpr int BMAP = 0; static constexpr bool ALIGN = true;
    bf16_t* ACT;
    __device__ __forceinline__ void mid(f32x4 (&)[2][2][4][2], const Unit&, int, int, int, int) const {}
    __device__ __forceinline__ void operator()(const f32x4 (&acc)[2][2][4][2], const Unit& u, int wr, int wc, int fr, int fq) const {
        const int rowb = u.pm * BM + wr * 64 + fr, col = u.pn * HALF + wc * 32 + 8 * fq;
        EPI_ROWS( f32x4 o[2];
            _Pragma("unroll") for (int n = 0; n < 2; ++n) _Pragma("unroll") for (int j = 0; j < 4; ++j) { const float gte = acc[ai][0][m][n][j]; o[n][j] = gte * __builtin_amdgcn_rcpf(1.f + __expf(-gte)) * acc[ai][1][m][n][j]; }
            *(u32x4*)(ACT + (size_t)row * FF + col) = pack8(o[0], o[1]); )
    }
};
struct FGU8 {
    static constexpr bool SPLIT = true;
    static constexpr int RELAX = 8; static constexpr bool MID = false; static constexpr int BMAP = 0; static constexpr bool ALIGN = true;
    unsigned char* ACT8;
    typedef unsigned u32x8_ __attribute__((ext_vector_type(8)));
    mutable u32x8_ pkv;
    __device__ __forceinline__ void mid(f32x4 (&)[2][2][4][2], const Unit&, int, int, int, int) const {}
    static __device__ __forceinline__ u32x2 row(const f32x4 (&acc)[2][2][4][2], int ai, int m) { f32x4 o[2];
        _Pragma("unroll") for (int n = 0; n < 2; ++n) _Pragma("unroll") for (int j = 0; j < 4; ++j) { const float gte = acc[ai][0][m][n][j]; o[n][j] = gte * __builtin_amdgcn_rcpf(__builtin_fmaf(__builtin_amdgcn_exp2f(gte * -1.44269504f), 1.0f / ACT_SCALE, 1.0f / ACT_SCALE)) * acc[ai][1][m][n][j]; }
        u32x2 pk; pk.x = pack4_fp8(o[0]); pk.y = pack4_fp8(o[1]); return pk; }
    __device__ __forceinline__ void operator()(const f32x4 (&acc)[2][2][4][2], const Unit&, int, int, int, int) const {
#pragma unroll
        for (int m = 0; m < 4; ++m) { const u32x2 pk = row(acc, 0, m); pkv[2 * m] = pk.x; pkv[2 * m + 1] = pk.y; }
    }
    __device__ __forceinline__ void store(const f32x4 (&acc)[2][2][4][2], const Unit& u, int wr, int wc, int fr, int fq) const {
        const int rowb = u.pm * BM + wr * 64 + fr, col = u.pn * HALF + wc * 32 + 8 * fq;
#pragma unroll
        for (int m = 0; m < 4; ++m) { u32x2 pk; pk.x = pkv[2 * m]; pk.y = pkv[2 * m + 1]; *(u32x2*)(ACT8 + (size_t)(rowb + m * 16) * FF + col) = pk; }
#pragma unroll
        for (int m = 0; m < 4; ++m) { const u32x2 pk = row(acc, 1, m); *(u32x2*)(ACT8 + (size_t)(rowb + HALF + m * 16) * FF + col) = pk; if (m & 1) asm volatile("" ::: "memory"); }
    }
};


#ifndef FDOWN_ALIGN
#define FDOWN_ALIGN true
#endif
struct FDown {
    static constexpr bool SPLIT = false; static constexpr int RELAX = Y_FP8 ? 8 : 0;
    static constexpr bool MID = false; static constexpr int BMAP = 1; static constexpr bool ALIGN = FDOWN_ALIGN;
    bf16_t* Y; MoeMap mm; int nostore;
    __device__ __forceinline__ void mid(f32x4 (&)[2][2][4][2], const Unit&, int, int, int, int) const {}
    __device__ __forceinline__ void operator()(const f32x4 (&acc)[2][2][4][2], const Unit& u, int wr, int wc, int fr, int fq) const {
        const int rowb = wr * 64 + fr, col = u.pn * BM + wc * 64 + 16 * fq;
        int dd[2][4];
        { const int e = __builtin_amdgcn_readfirstlane((int)mm.tile_e[u.pm]); const int base = (u.pm - __builtin_amdgcn_readfirstlane(mm.tbase[e])) * 256;
          if (e == NE) { _Pragma("unroll") for (int ai = 0; ai < 2; ++ai) _Pragma("unroll") for (int m = 0; m < 4; ++m) dd[ai][m] = (base + rowb + ai * HALF + m * 16) * 9 + 8; }
          else { const int c = __builtin_amdgcn_readfirstlane(mm.cnt[e]); const int* lp = mm.list + (size_t)e * T; int raw[2][4];
              _Pragma("unroll") for (int ai = 0; ai < 2; ++ai) _Pragma("unroll") for (int m = 0; m < 4; ++m) { const int idx = base + rowb + ai * HALF + m * 16; raw[ai][m] = lp[idx < c ? idx : 0]; }
              _Pragma("unroll") for (int ai = 0; ai < 2; ++ai) _Pragma("unroll") for (int m = 0; m < 4; ++m) { const int idx = base + rowb + ai * HALF + m * 16; dd[ai][m] = idx < c ? raw[ai][m] : -1; } } }
        EPI_ROWS( (void)row; const int d = nostore ? -1 : dd[ai][m]; if (Y_FP8 || d >= 0) {
            if (Y_FP8) { u32x4 pk; pk.x = pack4_fp8(acc[ai][0][m][0]); pk.y = pack4_fp8(acc[ai][0][m][1]); pk.z = pack4_fp8(acc[ai][1][m][0]); pk.w = pack4_fp8(acc[ai][1][m][1]);
                *(u32x4*)((unsigned char*)Y + (d >= 0 ? (size_t)d : (size_t)T * 9) * DM + col) = pk; }
            else { *(u32x4*)(Y + (size_t)d * DM + col) = pack8(acc[ai][0][m][0], acc[ai][0][m][1]); *(u32x4*)(Y + (size_t)d * DM + col + 8) = pack8(acc[ai][1][m][0], acc[ai][1][m][1]); } } )
    }
};
#undef EPI_ROWS
}

namespace att {
typedef short s16x4 __attribute__((ext_vector_type(4)));
constexpr int SLOT = 40960, VOFF = 24576, STG_ROW = 272;
__device__ __forceinline__ void glds16(const void* gsrc, LAS unsigned char* dst) { __builtin_amdgcn_global_load_lds((const unsigned*)gsrc, (LAS unsigned*)dst, 16, 0, 0); }
__device__ __forceinline__ s16x4 vtr(const LAS unsigned char* p) { return __builtin_bit_cast(s16x4, __builtin_amdgcn_ds_read_tr16_b64_v4i16((LAS s16x4*)p)); }
__device__ __forceinline__ float xhalf_max(float m) { auto rr = __builtin_amdgcn_permlane32_swap(__float_as_uint(m), __float_as_uint(m), false, false); return fmaxf(__uint_as_float(rr[0]), __uint_as_float(rr[1])); }
__device__ __forceinline__ float xhalf_sum(float m) { auto rr = __builtin_amdgcn_permlane32_swap(__float_as_uint(m), __float_as_uint(m), false, false); return __uint_as_float(rr[0]) + __uint_as_float(rr[1]); }
__device__ __forceinline__ bf16x8 packp(const f32x16& x, int s) { u32x4 p; p.x = pg8::cvt_pk_bf16(x[8 * s], x[8 * s + 1]); p.y = pg8::cvt_pk_bf16(x[8 * s + 2], x[8 * s + 3]); p.z = pg8::cvt_pk_bf16(x[8 * s + 4], x[8 * s + 5]); p.w = pg8::cvt_pk_bf16(x[8 * s + 6], x[8 * s + 7]); return __builtin_bit_cast(bf16x8, p); }
constexpr float THR = 8.0f;

template <int pf> __device__ __forceinline__ void mla_unit(LAS unsigned char* lds, const bf16_t* __restrict__ Q, const bf16_t* __restrict__ KN, const bf16_t* __restrict__ KR, const bf16_t* __restrict__ VM, bf16_t* __restrict__ O, int b, int h, int qb) {
    int tid = threadIdx.x; asm volatile("" : "+v"(tid));
    const int lane = tid & 63, w = __builtin_amdgcn_readfirstlane(tid >> 6), r = lane & 31, hh = lane >> 5;
    const size_t tb = (size_t)b * SEQ; const int q0 = qb * 256, NT = 4 * (qb + 1), jmax = 4 * qb + (w >> 1);
    const int dkey = 8 * w + (lane >> 3), dch = (lane & 7) ^ ((dkey >> 1) & 7);
    const bf16_t* ks0 = KN + ((tb + dkey) * MH + h) * NOPE + dch * 8;
    const bf16_t* ks2 = KR + (tb + dkey) * ROPE + dch * 8;
    const int vdb = w >> 1, vkq = 2 * (w & 1);
    const bf16_t* vs0 = VM + ((tb + 16 * vkq + (lane >> 2)) * MH + h) * VD + vdb * 32 + (lane & 3) * 8;
#define ATT_DMA(j_, slot_) do { if constexpr ((pf & 8) != 0) break; LAS unsigned char* sb_ = lds + (slot_) * SLOT; const size_t ko_ = (size_t)(j_) * 64 * MH * NOPE, ro_ = (size_t)(j_) * 64 * ROPE; \
        glds16(ks0 + ko_, sb_ + w * 1024); glds16(ks0 + ko_ + 64, sb_ + 8192 + w * 1024); glds16(ks2 + ro_, sb_ + 16384 + w * 1024); \
        glds16(vs0 + ko_, sb_ + VOFF + vdb * 4096 + vkq * 1024); glds16(vs0 + ko_ + (size_t)16 * MH * VD, sb_ + VOFF + vdb * 4096 + (vkq + 1) * 1024); } while (0)
    ATT_DMA(0, 0);
    bf16x8 qf[12];
    { const bf16_t* qp = Q + ((tb + q0 + 32 * w + r) * MH + h) * QKD + 8 * hh;
#pragma unroll
      for (int ks = 0; ks < 12; ++ks) qf[ks] = *(const bf16x8*)(qp + 16 * ks); }
    ATT_DMA(1, 1);
    float mrun = -1e30f, l = 0.f; f32x16 ot[4];
#pragma unroll
    for (int d = 0; d < 4; ++d)
#pragma unroll
        for (int i = 0; i < 16; ++i) ot[d][i] = 0.f;
    int kofs[4];
#pragma unroll
    for (int q = 0; q < 4; ++q) kofs[q] = r * 128 + (((2 * q + hh) ^ ((r >> 1) & 7)) << 4);
    const int vro = VOFF + (4 * hh + ((lane & 15) >> 2)) * 64 + ((lane >> 4) & 1) * 32 + (lane & 3) * 8;
    bf16x8 kf[2][4]; bf16x8 vf[2][4];
#define ATT_LOADK(B_, kb_) do { _Pragma("unroll") for (int i_ = 0; i_ < 2; ++i_) { const int ks_ = 2 * (kb_) + i_; const LAS unsigned char* kp_ = sbk + (ks_ >> 2) * 8192 + kofs[ks_ & 3]; \
        kf[B_][2 * i_] = *(const LAS bf16x8*)(kp_); kf[B_][2 * i_ + 1] = *(const LAS bf16x8*)(kp_ + 4096); } } while (0)
#define ATT_PIN4(A_) asm volatile("" : "+v"(A_[0]), "+v"(A_[1]), "+v"(A_[2]), "+v"(A_[3]) :: "memory")
#define ATT_LOADV(B_, bs_) do { _Pragma("unroll") for (int d_ = 0; d_ < 4; ++d_) { const LAS unsigned char* vp_ = sbv + d_ * 4096 + (bs_) * 1024; const s16x4 lo_ = vtr(vp_), hi_ = vtr(vp_ + 512); \
        vf[B_][d_] = __builtin_shufflevector(lo_, hi_, 0, 1, 2, 3, 4, 5, 6, 7); } } while (0)
    f32x16 x0, x1;
    int slot = 0;
    for (int j = 0; j < NT; ++j) {
        if (j + 1 < NT) asm volatile("s_waitcnt vmcnt(5) lgkmcnt(0)" ::: "memory"); else asm volatile("s_waitcnt vmcnt(0) lgkmcnt(0)" ::: "memory");
        __builtin_amdgcn_s_barrier();
        asm volatile("" ::: "memory");
        if (j + 2 < NT) { const int s2 = slot == 0 ? 2 : slot - 1; ATT_DMA(j + 2, s2); }
        if (j <= jmax) {
            const LAS unsigned char* sbk = lds + slot * SLOT; const LAS unsigned char* sbv = lds + slot * SLOT + vro;
#pragma unroll
            for (int i = 0; i < 16; ++i) { x0[i] = 0.f; x1[i] = 0.f; }
            ATT_LOADK(0, 0);
#pragma unroll
            for (int kb = 0; kb < 6; ++kb) {
                if (kb < 5) ATT_LOADK((kb + 1) & 1, kb + 1); else ATT_LOADV(0, 0);
                ATT_PIN4(kf[kb & 1]);
                if constexpr ((pf & 1) != 0) continue;
                x0 = MFMA32(kf[kb & 1][0], qf[2 * kb], x0); x1 = MFMA32(kf[kb & 1][1], qf[2 * kb], x1);
                x0 = MFMA32(kf[kb & 1][2], qf[2 * kb + 1], x0); x1 = MFMA32(kf[kb & 1][3], qf[2 * kb + 1], x1);
            }
            if (j == jmax) { const int qrel = 32 * (w & 1) + r;
#pragma unroll
                for (int i = 0; i < 16; ++i) { const int k0 = crow(i, hh); if (k0 > qrel) x0[i] = -1e30f; if (k0 + 32 > qrel) x1[i] = -1e30f; } }
            float rm = fmaxf(x0[0], x1[0]);
#pragma unroll
            for (int i = 1; i < 16; ++i) rm = fmaxf(rm, fmaxf(x0[i], x1[i]));
            rm = xhalf_max(rm);
            if (__any(rm > mrun + THR)) { const float mn = fmaxf(mrun, rm), f = __builtin_amdgcn_exp2f(mrun - mn); mrun = mn; l *= f;
#pragma unroll
                for (int d = 0; d < 4; ++d)
#pragma unroll
                    for (int i = 0; i < 16; ++i) ot[d][i] *= f; }
            float ps = 0.f;
#pragma unroll
            for (int i = 0; i < 16; ++i) { if constexpr ((pf & 2) == 0) { x0[i] = __builtin_amdgcn_exp2f(x0[i] - mrun); x1[i] = __builtin_amdgcn_exp2f(x1[i] - mrun); } ps += x0[i] + x1[i]; }
            l += ps;
#pragma unroll
            for (int bs = 0; bs < 4; ++bs) {
                if (bs < 3) ATT_LOADV((bs + 1) & 1, bs + 1);
                ATT_PIN4(vf[bs & 1]);
                const bf16x8 pa = packp((bs >> 1) ? x1 : x0, bs & 1);
                if constexpr ((pf & 4) != 0) continue;
#pragma unroll
                for (int d = 0; d < 4; ++d) ot[d] = MFMA32(vf[bs & 1][d], pa, ot[d]);
            }
        }
        slot = slot == 2 ? 0 : slot + 1;
    }
#undef ATT_LOADK
#undef ATT_PIN4
#undef ATT_LOADV
    l = xhalf_sum(l); const float inv = 1.0f / l;
    asm volatile("s_waitcnt lgkmcnt(0)" ::: "memory");
    __builtin_amdgcn_s_barrier();
    asm volatile("" ::: "memory");
    LAS unsigned char* stg = lds + w * (32 * STG_ROW);
    if (MERGE_FP8) {
        const float sc = inv * O8_SCALE;
#pragma unroll
        for (int d = 0; d < 4; ++d)
#pragma unroll
            for (int gq = 0; gq < 4; ++gq) { const f32x4 q4 = (f32x4){ot[d][4 * gq] * sc, ot[d][4 * gq + 1] * sc, ot[d][4 * gq + 2] * sc, ot[d][4 * gq + 3] * sc};
                *(LAS unsigned*)(stg + r * 144 + (32 * d + 8 * gq + 4 * hh)) = pack4_fp8_(q4); }
        asm volatile("s_waitcnt lgkmcnt(0)" ::: "memory");
        unsigned char* op8 = (unsigned char*)O + (tb + q0 + 32 * w) * DM + h * VD;
#pragma unroll
        for (int it = 0; it < 4; ++it) { const int c = it * 64 + lane, row = c >> 3, ch = c & 7; const u32x4 v = *(const LAS u32x4*)(stg + row * 144 + ch * 16); *(u32x4*)(op8 + (size_t)row * DM + ch * 16) = v; }
    } else {
#pragma unroll
    for (int d = 0; d < 4; ++d)
#pragma unroll
        for (int gq = 0; gq < 4; ++gq) { u32x2 pk; pk.x = pg8::cvt_pk_bf16(ot[d][4 * gq] * inv, ot[d][4 * gq + 1] * inv); pk.y = pg8::cvt_pk_bf16(ot[d][4 * gq + 2] * inv, ot[d][4 * gq + 3] * inv);
            *(LAS u32x2*)(stg + r * STG_ROW + (32 * d + 8 * gq + 4 * hh) * 2) = pk; }
    asm volatile("s_waitcnt lgkmcnt(0)" ::: "memory");
    bf16_t* op = O + (tb + q0 + 32 * w) * DM + h * VD;
#pragma unroll
    for (int it = 0; it < 8; ++it) { const int c = it * 64 + lane, row = c >> 4, ch = c & 15; const u32x4 v = *(const LAS u32x4*)(stg + row * STG_ROW + ch * 16); *(u32x4*)(op + (size_t)row * DM + ch * 8) = v; }
    }
    asm volatile("s_waitcnt lgkmcnt(0)" ::: "memory");
    __builtin_amdgcn_s_barrier();
    asm volatile("" ::: "memory");
#undef ATT_DMA
}
template <int pf> __device__ __forceinline__ void mla_phase(LAS unsigned char* lds, const bf16_t* Q, const bf16_t* KN, const bf16_t* KR, const bf16_t* VM, bf16_t* O, int G, int bid) {
    const int vcu = (G % 8 == 0) ? (bid % 8) * (G / 8) + bid / 8 : bid;
    for (int pu = vcu; pu < NB * MH * 4; pu += G) { const int bh = pu >> 2, s = pu & 3;
        mla_unit<pf>(lds, Q, KN, KR, VM, O, bh >> 3, bh & 7, 7 - s);
        mla_unit<pf>(lds, Q, KN, KR, VM, O, bh >> 3, bh & 7, s); }
}

constexpr int SW_K = 0, SW_V = 32768, SW_LUT = 65536, SW_STG = 65536 + 2048, SW_STG_ROW = 144;
__device__ __forceinline__ void swa_unit(LAS unsigned char* lds, const bf16_t* __restrict__ QS, const bf16_t* __restrict__ KS, const bf16_t* __restrict__ VS, gfp sinks, gfp rel, bf16_t* __restrict__ O, int b, int kvh, int n) {
    int tid = threadIdx.x; asm volatile("" : "+v"(tid));
    const int lane = tid & 63, w = __builtin_amdgcn_readfirstlane(tid >> 6), r = lane & 31, hh = lane >> 5;
    const size_t tb = (size_t)b * SEQ; const int ks0 = n > 0 ? 128 * (n - 1) : 0;
    const int g = w >> 1, hq = kvh * 4 + g;
    { const bf16_t* ksrc = KS + ((tb + ks0 + lane) * SKH + kvh) * SHD + w * 8;
#pragma unroll
      for (int i = 0; i < 4; ++i) glds16(ksrc + (size_t)i * 64 * SKH * SHD, lds + SW_K + w * 4096 + i * 1024);
      const int db = w >> 2; const bf16_t* vsrc = VS + ((tb + ks0 + 64 * (w & 3) + (lane >> 2)) * SKH + kvh) * SHD + db * 32 + (lane & 3) * 8;
#pragma unroll
      for (int i = 0; i < 4; ++i) glds16(vsrc + (size_t)i * 16 * SKH * SHD, lds + SW_V + db * 16384 + (4 * (w & 3) + i) * 1024);
      ((LAS float*)(lds + SW_LUT))[tid] = rel[T5_BUCKET[tid & 127] * SQH + kvh * 4 + (tid >> 7)] * LOG2E; }
    bf16x8 qfa[2][4];
#pragma unroll
    for (int sbq = 0; sbq < 2; ++sbq) { const bf16_t* qp = QS + ((tb + 128 * n + 64 * (w & 1) + 32 * sbq + r) * SQH + hq) * SHD + 8 * hh;
#pragma unroll
        for (int ks = 0; ks < 4; ++ks) qfa[sbq][ks] = *(const bf16x8*)(qp + 16 * ks); }
    asm volatile("s_waitcnt vmcnt(0) lgkmcnt(0)" ::: "memory");
    __builtin_amdgcn_s_barrier();
    asm volatile("" ::: "memory");
    const LAS float* lut = (const LAS float*)(lds + SW_LUT) + g * 128;
    const float sink = sinks[hq] * LOG2E;
    const int kro = hh * 4096 + r * 16, vro = (4 * hh + ((lane & 15) >> 2)) * 64 + ((lane >> 4) & 1) * 32 + (lane & 3) * 8;
    LAS unsigned char* stg = lds + SW_STG + w * (32 * SW_STG_ROW);
#pragma unroll
    for (int sb = 0; sb < 2; ++sb) {
        const int qs = 128 * n + 64 * (w & 1) + 32 * sb;
        f32x16 x[5]; float mx = sink;
        bf16x8 kf[2][4];
#define SW_LOADK(B_, dl_) do { if (qs - 32 * (dl_) >= 0) { const LAS unsigned char* kp_ = lds + SW_K + kro + (qs - 32 * (dl_) - ks0) * 16; \
            _Pragma("unroll") for (int ks_ = 0; ks_ < 4; ++ks_) kf[B_][ks_] = *(const LAS bf16x8*)(kp_ + ks_ * 8192); } } while (0)
        SW_LOADK(0, 0);
#pragma unroll
        for (int dl = 0; dl < 5; ++dl) {
            const int kpos0 = qs - 32 * dl;
            if (dl < 4) SW_LOADK((dl + 1) & 1, dl + 1);
#pragma unroll
            for (int i = 0; i < 16; ++i) x[dl][i] = 0.f;
            if (kpos0 >= 0) {
                asm volatile("" : "+v"(kf[dl & 1][0]), "+v"(kf[dl & 1][1]), "+v"(kf[dl & 1][2]), "+v"(kf[dl & 1][3]) :: "memory");
#pragma unroll
                for (int ks = 0; ks < 4; ++ks) x[dl] = MFMA32(kf[dl & 1][ks], qfa[sb][ks], x[dl]);
#pragma unroll
                for (int i = 0; i < 16; ++i) { const int dist = 32 * dl + r - crow(i, hh); const bool ok = dist >= 0 && dist < 128; const float bias = lut[ok ? dist : 0];
                    x[dl][i] = ok ? x[dl][i] + bias : -1e30f; mx = fmaxf(mx, x[dl][i]); }
            } else {
#pragma unroll
                for (int i = 0; i < 16; ++i) x[dl][i] = -1e30f;
            }
        }
#undef SW_LOADK
        mx = xhalf_max(mx);
        float l = 0.f;
#pragma unroll
        for (int dl = 0; dl < 5; ++dl)
#pragma unroll
            for (int i = 0; i < 16; ++i) { x[dl][i] = __builtin_amdgcn_exp2f(x[dl][i] - mx); l += x[dl][i]; }
        l = xhalf_sum(l) + __builtin_amdgcn_exp2f(sink - mx);
        f32x16 ot[2];
#pragma unroll
        for (int d = 0; d < 2; ++d)
#pragma unroll
            for (int i = 0; i < 16; ++i) ot[d][i] = 0.f;
        bf16x8 vfb[2][4];
#define SW_LOADV(B_, dl_) do { if (qs - 32 * (dl_) >= 0) { _Pragma("unroll") for (int s2_ = 0; s2_ < 2; ++s2_) _Pragma("unroll") for (int d_ = 0; d_ < 2; ++d_) { \
            const LAS unsigned char* vp_ = lds + SW_V + d_ * 16384 + (qs - 32 * (dl_) - ks0 + 16 * s2_) * 64 + vro; const s16x4 lo_ = vtr(vp_), hi_ = vtr(vp_ + 512); \
            vfb[B_][2 * s2_ + d_] = __builtin_shufflevector(lo_, hi_, 0, 1, 2, 3, 4, 5, 6, 7); } } } while (0)
        SW_LOADV(0, 0);
#pragma unroll
        for (int dl = 0; dl < 5; ++dl) {
            const int kpos0 = qs - 32 * dl;
            if (dl < 4) SW_LOADV((dl + 1) & 1, dl + 1);
            if (kpos0 >= 0) {
                asm volatile("" : "+v"(vfb[dl & 1][0]), "+v"(vfb[dl & 1][1]), "+v"(vfb[dl & 1][2]), "+v"(vfb[dl & 1][3]) :: "memory");
#pragma unroll
                for (int s2 = 0; s2 < 2; ++s2) { const bf16x8 pa = packp(x[dl], s2);
#pragma unroll
                    for (int d = 0; d < 2; ++d) ot[d] = MFMA32(vfb[dl & 1][2 * s2 + d], pa, ot[d]); }
            }
        }
#undef SW_LOADV
        const float inv = 1.0f / l;
        if (MERGE_FP8) {
            const float sc = inv * O8_SCALE;
#pragma unroll
            for (int d = 0; d < 2; ++d)
#pragma unroll
                for (int gq = 0; gq < 4; ++gq) { const f32x4 q4 = (f32x4){ot[d][4 * gq] * sc, ot[d][4 * gq + 1] * sc, ot[d][4 * gq + 2] * sc, ot[d][4 * gq + 3] * sc};
                    *(LAS unsigned*)(stg + r * 80 + (32 * d + 8 * gq + 4 * hh)) = pack4_fp8_(q4); }
            asm volatile("s_waitcnt lgkmcnt(0)" ::: "memory");
            unsigned char* op8 = (unsigned char*)O + (tb + qs) * DM + 1024 + hq * SHD;
#pragma unroll
            for (int it = 0; it < 2; ++it) { const int c = it * 64 + lane, row = c >> 2, ch = c & 3; const u32x4 v = *(const LAS u32x4*)(stg + row * 80 + ch * 16); *(u32x4*)(op8 + (size_t)row * DM + ch * 16) = v; }
            asm volatile("s_waitcnt lgkmcnt(0)" ::: "memory");
        } else {
#pragma unroll
        for (int d = 0; d < 2; ++d)
#pragma unroll
            for (int gq = 0; gq < 4; ++gq) { u32x2 pk; pk.x = pg8::cvt_pk_bf16(ot[d][4 * gq] * inv, ot[d][4 * gq + 1] * inv); pk.y = pg8::cvt_pk_bf16(ot[d][4 * gq + 2] * inv, ot[d][4 * gq + 3] * inv);
                *(LAS u32x2*)(stg + r * SW_STG_ROW + (32 * d + 8 * gq + 4 * hh) * 2) = pk; }
        asm volatile("s_waitcnt lgkmcnt(0)" ::: "memory");
        bf16_t* op = O + (tb + qs) * DM + 1024 + hq * SHD;
#pragma unroll
        for (int it = 0; it < 4; ++it) { const int c = it * 64 + lane, row = c >> 3, ch = c & 7; const u32x4 v = *(const LAS u32x4*)(stg + row * SW_STG_ROW + ch * 16); *(u32x4*)(op + (size_t)row * DM + ch * 8) = v; }
        asm volatile("s_waitcnt lgkmcnt(0)" ::: "memory");
        }
    }
    __builtin_amdgcn_s_barrier();
    asm volatile("" ::: "memory");
}
__device__ __forceinline__ void swa_phase(LAS unsigned char* lds, const bf16_t* QS, const bf16_t* KS, const bf16_t* VS, gfp sinks, gfp rel, bf16_t* O, int G, int bid) {
    const int vcu = (G % 8 == 0) ? (bid % 8) * (G / 8) + bid / 8 : bid;
    for (int u = vcu; u < NB * SKH * 16; u += G) { const int n = u & 15, kvh = (u >> 4) & 3, b = u >> 6; swa_unit(lds, QS, KS, VS, sinks, rel, O, b, kvh, n); }
}
}

namespace lnr {
constexpr int A_LO = 65536, P_OFF = 0, LOG_OFF = 32768;
constexpr int SEL_OFF = 131072 + 4096, LCNT_OFF = 131072 + 8192, BASE_OFF = 131072 + 8448, MAXU = 8;
#define MFMA16(a, b, c) __builtin_amdgcn_mfma_f32_16x16x32_bf16((a), (b), (c), 0, 0, 0)
__device__ __forceinline__ void phase(LAS unsigned char* lds, const bf16_t* __restrict__ hpre, gfp g, gfp bta, const bf16_t* __restrict__ WH, const bf16_t* __restrict__ WL,
                                      gfp rbias, bf16_t* __restrict__ HBo, unsigned char* __restrict__ HB8o, float* __restrict__ topwo, int* __restrict__ list, int* __restrict__ dlst, unsigned* __restrict__ cnt, int G, int bid) {
    int tid = threadIdx.x; asm volatile("" : "+v"(tid));
    const int lane = tid & 63, w = __builtin_amdgcn_readfirstlane(tid >> 6);
    constexpr int NU = T / 16;
    LAS int* LCNT = (LAS int*)(lds + LCNT_OFF); LAS int* BASE = (LAS int*)(lds + BASE_OFF); LAS int* SEL = (LAS int*)(lds + SEL_OFF);
    if (tid < 64) LCNT[tid] = 0;
    u32x4 vr[2][4];
    int u = bid, nloc = 0;
    if (u < NU) {
#pragma unroll
        for (int rr = 0; rr < 2; ++rr) { const u32x4* xr = (const u32x4*)(hpre + (size_t)(16 * u + 2 * w + rr) * DM) + lane;
#pragma unroll
            for (int j = 0; j < 4; ++j) vr[rr][j] = xr[64 * j]; }
    }
    const float rb = rbias[lane];
    for (; u < NU && nloc < MAXU; u += G, ++nloc) {
        const int arow = lane & 15, quad = lane >> 4;
        bf16x8 bh[3][4];
        const bf16_t* wb = WH + (size_t)w * 16384 + lane * 8; asm volatile("" : "+v"(wb));
#define LNR_LOADB(S_, ks_) _Pragma("unroll") for (int nb = 0; nb < 4; ++nb) { bh[S_][nb] = *(const bf16x8*)(wb + ((ks_) * 4 + nb) * 512); }
        LNR_LOADB(0, 0) LNR_LOADB(1, 1)
#pragma unroll
        for (int rr = 0; rr < 2; ++rr) {
            const int lr = 2 * w + rr; const size_t row = (size_t)16 * u + lr;
            f32x4 va[4], vb[4]; float s = 0.f;
#pragma unroll
            for (int j = 0; j < 4; ++j) { pg8::unpack8(vr[rr][j], va[j], vb[j]); s += ((va[j].x + va[j].y) + (va[j].z + va[j].w)) + ((vb[j].x + vb[j].y) + (vb[j].z + vb[j].w)); }
            const float mean = wave_sum(s) * (1.f / DM); float s2 = 0.f;
#pragma unroll
            for (int j = 0; j < 4; ++j) { va[j] = va[j] - mean; vb[j] = vb[j] - mean; s2 += ((va[j].x * va[j].x + va[j].y * va[j].y) + (va[j].z * va[j].z + va[j].w * va[j].w)) + ((vb[j].x * vb[j].x + vb[j].y * vb[j].y) + (vb[j].z * vb[j].z + vb[j].w * vb[j].w)); }
            const float rstd = 1.0f / sqrtf(wave_sum(s2) * (1.f / DM) + LN_EPS);
#pragma unroll
            for (int j = 0; j < 4; ++j) {
                const int c = 8 * lane + 512 * j;
                const f32x4 ya = va[j] * rstd * *(const GAS f32x4*)(g + c) + *(const GAS f32x4*)(bta + c), yb = vb[j] * rstd * *(const GAS f32x4*)(g + c + 4) + *(const GAS f32x4*)(bta + c + 4);
                u32x4 oh, ol;
#pragma unroll
                for (int q = 0; q < 2; ++q) { const unsigned ha = pg8::cvt_pk_bf16(ya[2 * q], ya[2 * q + 1]), hb = pg8::cvt_pk_bf16(yb[2 * q], yb[2 * q + 1]); oh[q] = ha; oh[2 + q] = hb;
                    ol[q] = pg8::cvt_pk_bf16(ya[2 * q] - __uint_as_float(ha << 16), ya[2 * q + 1] - __uint_as_float(ha & 0xffff0000u));
                    ol[2 + q] = pg8::cvt_pk_bf16(yb[2 * q] - __uint_as_float(hb << 16), yb[2 * q + 1] - __uint_as_float(hb & 0xffff0000u)); }
                *(u32x4*)(HBo + row * DM + c) = oh;
                if (MOE_FP8) { u32x2 p8; p8.x = pack4_fp8_(ya * H8_SCALE); p8.y = pack4_fp8_(yb * H8_SCALE); *(u32x2*)(HB8o + row * DM + c) = p8; }
                const int off = lr * 4096 + (((lane + 64 * j) ^ lr) << 4);
                *(LAS u32x4*)(lds + off) = oh; *(LAS u32x4*)(lds + A_LO + off) = ol;
            }
        }
        asm volatile("s_waitcnt lgkmcnt(0)" ::: "memory"); __builtin_amdgcn_s_barrier(); asm volatile("" ::: "memory");
        f32x4 acc[4];
#pragma unroll
        for (int nb = 0; nb < 4; ++nb) acc[nb] = (f32x4){0.f, 0.f, 0.f, 0.f};
#define LNR_STEP(S_, ks_) do { asm volatile("" : "+v"(bh[S_][0]), "+v"(bh[S_][1]), "+v"(bh[S_][2]), "+v"(bh[S_][3]) :: "memory");     \
            const int kc = 32 * w + 4 * (ks_) + quad; \
            const bf16x8 a_h = *(const LAS bf16x8*)(lds + arow * 4096 + ((kc ^ arow) << 4)), a_l = *(const LAS bf16x8*)(lds + A_LO + arow * 4096 + ((kc ^ arow) << 4)); \
            _Pragma("unroll") for (int nb = 0; nb < 4; ++nb) { acc[nb] = MFMA16(a_l, bh[S_][nb], acc[nb]); acc[nb] = MFMA16(a_h, bh[S_][nb], acc[nb]); } } while (0)
#pragma unroll
        for (int ks = 0; ks < 8; ++ks) {
            if (ks + 2 < 8) { LNR_LOADB((ks + 2) % 3, ks + 2) }
            LNR_STEP(ks % 3, ks);
        }
#undef LNR_STEP
        { const int un = u + G; if (un < NU && nloc + 1 < MAXU) {
#pragma unroll
            for (int rr = 0; rr < 2; ++rr) { const u32x4* xr = (const u32x4*)(hpre + (size_t)(16 * un + 2 * w + rr) * DM) + lane;
#pragma unroll
                for (int j = 0; j < 4; ++j) vr[rr][j] = xr[64 * j]; } } }
        asm volatile("s_waitcnt lgkmcnt(0)" ::: "memory"); __builtin_amdgcn_s_barrier(); asm volatile("" ::: "memory");
        { LAS float* P = (LAS float*)(lds + P_OFF) + w * 1024;
#pragma unroll
          for (int nb = 0; nb < 4; ++nb)
#pragma unroll
              for (int j = 0; j < 4; ++j) P[(4 * quad + j) * 64 + 16 * nb + arow] = acc[nb][j]; }
        asm volatile("s_waitcnt lgkmcnt(0)" ::: "memory"); __builtin_amdgcn_s_barrier(); asm volatile("" ::: "memory");
        { const LAS float* P = (const LAS float*)(lds + P_OFF); LAS float* LOG = (LAS float*)(lds + LOG_OFF);
#pragma unroll
          for (int o = 0; o < 2; ++o) { const int idx = tid + 512 * o; float sum = P[idx];
#pragma unroll
              for (int ww = 1; ww < 8; ++ww) sum += P[ww * 1024 + idx];
              LOG[idx] = sum; } }
        asm volatile("s_waitcnt lgkmcnt(0)" ::: "memory"); __builtin_amdgcn_s_barrier(); asm volatile("" ::: "memory");
#pragma unroll
        for (int rr = 0; rr < 2; ++rr) {
            const int lr = 2 * w + rr; const int t = 16 * u + lr;
            const float score = sigmoidf_(((const LAS float*)(lds + LOG_OFF))[lr * 64 + lane]); const float sel = score + rb;
            float m1 = sel;
            m1 = fmaxf(m1, __shfl_xor(m1, 1)); m1 = fmaxf(m1, __shfl_xor(m1, 2)); m1 = fmaxf(m1, __shfl_xor(m1, 4));
            int i1 = (sel == m1) ? lane : 64;
            i1 = min(i1, __shfl_xor(i1, 1)); i1 = min(i1, __shfl_xor(i1, 2)); i1 = min(i1, __shfl_xor(i1, 4));
            float m2 = (lane == i1) ? -INFINITY : sel;
            m2 = fmaxf(m2, __shfl_xor(m2, 1)); m2 = fmaxf(m2, __shfl_xor(m2, 2)); m2 = fmaxf(m2, __shfl_xor(m2, 4));
            const float gs = m1 + m2; const int gi = lane >> 3;
            int grank = 0;
#pragma unroll
            for (int gg = 0; gg < 8; ++gg) { const float o = __int_as_float(__builtin_amdgcn_readlane(__float_as_int(gs), 8 * gg)); grank += (o > gs || (o == gs && gg < gi)) ? 1 : 0; }
            const float selm = grank < 4 ? sel : -INFINITY;
            int rank = 0;
#pragma unroll 4
            for (int ll = 0; ll < 64; ++ll) { const float o = __int_as_float(__builtin_amdgcn_readlane(__float_as_int(selm), ll)); rank += (o > selm || (o == selm && ll < lane)) ? 1 : 0; }
            const bool chosen = rank < TOPK;
            const float wsum = wave_sum(chosen ? score : 0.f);
            if (chosen) { const int lrank = atomicAdd((int*)(LCNT + lane), 1); SEL[(nloc * 16 + lr) * 8 + rank] = (lrank << 8) | lane; topwo[(size_t)t * TOPK + rank] = score / wsum * 2.5f; }
        }
        asm volatile("s_waitcnt lgkmcnt(0)" ::: "memory"); __builtin_amdgcn_s_barrier(); asm volatile("" ::: "memory");
    }
    __syncthreads();
    if (tid < 64) BASE[tid] = (int)atomicAdd(cnt + tid, (unsigned)LCNT[tid]);
    __syncthreads();
    for (int idx = tid; idx < nloc * 128; idx += 512) { const int i = idx >> 7, lr = (idx >> 3) & 15, k = idx & 7; const int t = 16 * (bid + i * G) + lr; const int sv = SEL[idx]; const int e = sv & 255, p = BASE[e] + (sv >> 8);
        list[(size_t)e * T + p] = t; dlst[(size_t)e * T + p] = t * 9 + k; }
}
#undef LNR_LOADB
#undef MFMA16
}

__device__ __forceinline__ void final_phase8(const bf16_t* __restrict__ HBp, const unsigned char* __restrict__ Yp, const float* __restrict__ topwp, gfp g, gfp bta, float* __restrict__ outp, int gw, int NGW, int lane) {
    typedef float f32x2_ __attribute__((ext_vector_type(2)));
    for (int t = gw; t < T; t += NGW) {
        u32x4 ry[9][2], rh[2][2];
#pragma unroll
        for (int j = 0; j < 2; ++j) { rh[j][0] = *(const u32x4*)(HBp + (size_t)t * DM + 16 * lane + 1024 * j); rh[j][1] = *(const u32x4*)(HBp + (size_t)t * DM + 16 * lane + 1024 * j + 8); }
#pragma unroll
        for (int k = 0; k < 9; ++k)
#pragma unroll
            for (int j = 0; j < 2; ++j) ry[k][j] = *(const u32x4*)(Yp + ((size_t)t * 9 + k) * DM + 16 * lane + 1024 * j);
        float wk[9];
#pragma unroll
        for (int k = 0; k < 8; ++k) wk[k] = topwp[(size_t)t * 8 + k] * (1.0f / Y_SCALE);
        wk[8] = 1.0f / Y_SCALE;
#pragma unroll
        for (int k = 0; k < 9; ++k)
#pragma unroll
            for (int j = 0; j < 2; ++j) asm volatile("" : "+v"(ry[k][j]));
#pragma unroll
        for (int j = 0; j < 2; ++j) { asm volatile("" : "+v"(rh[j][0])); asm volatile("" : "+v"(rh[j][1])); }
        float v[2][16]; float s = 0.f;
#pragma unroll
        for (int j = 0; j < 2; ++j) { f32x4 a, b, c, d; pg8::unpack8(rh[j][0], a, b); pg8::unpack8(rh[j][1], c, d);
#pragma unroll
            for (int q = 0; q < 4; ++q) { v[j][q] = a[q] * ALPHA; v[j][4 + q] = b[q] * ALPHA; v[j][8 + q] = c[q] * ALPHA; v[j][12 + q] = d[q] * ALPHA; } }
#pragma unroll
        for (int k = 0; k < 9; ++k)
#pragma unroll
            for (int j = 0; j < 2; ++j) { asm volatile("" : "+v"(ry[k][j]));
#pragma unroll
                for (int q = 0; q < 4; ++q) { const int wd = (int)ry[k][j][q]; const f32x2_ lo = __builtin_amdgcn_cvt_pk_f32_fp8(wd, false), hi = __builtin_amdgcn_cvt_pk_f32_fp8(wd, true);
                    v[j][4 * q] += lo[0] * wk[k]; v[j][4 * q + 1] += lo[1] * wk[k]; v[j][4 * q + 2] += hi[0] * wk[k]; v[j][4 * q + 3] += hi[1] * wk[k]; }
                _Pragma("unroll") for (int q = 0; q < 16; ++q) asm volatile("" : "+v"(v[j][q])); }
#pragma unroll
        for (int j = 0; j < 2; ++j)
#pragma unroll
            for (int q = 0; q < 16; q += 4) s += (v[j][q] + v[j][q + 1]) + (v[j][q + 2] + v[j][q + 3]);
        const float mean = wave_sum(s) * (1.f / DM); float s2 = 0.f;
#pragma unroll
        for (int j = 0; j < 2; ++j)
#pragma unroll
            for (int q = 0; q < 16; ++q) { v[j][q] -= mean; s2 += v[j][q] * v[j][q]; }
        const float rstd = 1.0f / sqrtf(wave_sum(s2) * (1.f / DM) + LN_EPS);
#pragma unroll
        for (int j = 0; j < 2; ++j)
#pragma unroll
            for (int q = 0; q < 4; ++q) { const int c = 16 * lane + 1024 * j + 4 * q; const f32x4 gg = *(const GAS f32x4*)(g + c), bb = *(const GAS f32x4*)(bta + c);
                f32x4 o; o[0] = v[j][4 * q] * rstd * gg[0] + bb[0]; o[1] = v[j][4 * q + 1] * rstd * gg[1] + bb[1]; o[2] = v[j][4 * q + 2] * rstd * gg[2] + bb[2]; o[3] = v[j][4 * q + 3] * rstd * gg[3] + bb[3];
                *(f32x4*)(outp + (size_t)t * DM + c) = o; }
    }
}
__device__ __forceinline__ void final_phase(const bf16_t* __restrict__ HBp, const bf16_t* __restrict__ Yp, const float* __restrict__ topwp, gfp g, gfp bta, float* __restrict__ outp, int gw, int NGW, int lane) {
    for (int t = gw; t < T; t += NGW) {
        u32x4 raw[10][4];
#pragma unroll
        for (int j = 0; j < 4; ++j) raw[9][j] = *(const u32x4*)(HBp + (size_t)t * DM + 8 * lane + 512 * j);
#pragma unroll
        for (int k = 0; k < 9; ++k)
#pragma unroll
            for (int j = 0; j < 4; ++j) raw[k][j] = *(const u32x4*)(Yp + ((size_t)t * 9 + k) * DM + 8 * lane + 512 * j);
        float wk[9];
#pragma unroll
        for (int k = 0; k < 8; ++k) wk[k] = topwp[(size_t)t * 8 + k];
        wk[8] = 1.f;
#pragma unroll
        for (int k = 0; k < 10; ++k)
#pragma unroll
            for (int j = 0; j < 4; ++j) asm volatile("" : "+v"(raw[k][j]));
        f32x4 va[4], vb[4]; float s = 0.f;
#pragma unroll
        for (int j = 0; j < 4; ++j) { f32x4 a, b; pg8::unpack8(raw[9][j], a, b); va[j] = a * ALPHA; vb[j] = b * ALPHA; }
#pragma unroll
        for (int k = 0; k < 9; ++k)
#pragma unroll
            for (int j = 0; j < 4; ++j) { f32x4 a, b; pg8::unpack8(raw[k][j], a, b); va[j] += a * wk[k]; vb[j] += b * wk[k]; }
#pragma unroll
        for (int j = 0; j < 4; ++j) s += ((va[j].x + va[j].y) + (va[j].z + va[j].w)) + ((vb[j].x + vb[j].y) + (vb[j].z + vb[j].w));
        const float mean = wave_sum(s) * (1.f / DM); float s2 = 0.f;
#pragma unroll
        for (int j = 0; j < 4; ++j) { va[j] = va[j] - mean; vb[j] = vb[j] - mean; s2 += ((va[j].x * va[j].x + va[j].y * va[j].y) + (va[j].z * va[j].z + va[j].w * va[j].w)) + ((vb[j].x * vb[j].x + vb[j].y * vb[j].y) + (vb[j].z * vb[j].z + vb[j].w * vb[j].w)); }
        const float rstd = 1.0f / sqrtf(wave_sum(s2) * (1.f / DM) + LN_EPS);
#pragma unroll
        for (int j = 0; j < 4; ++j) { const int c = 8 * lane + 512 * j;
            *(f32x4*)(outp + (size_t)t * DM + c) = va[j] * rstd * *(const GAS f32x4*)(g + c) + *(const GAS f32x4*)(bta + c);
            *(f32x4*)(outp + (size_t)t * DM + c + 4) = vb[j] * rstd * *(const GAS f32x4*)(g + c + 4) + *(const GAS f32x4*)(bta + c + 4); }
    }
}

#define XB_TMO      128
#define XB_XCNT(j)  (256  + 64 * (j))
#define XB_XSUB(j)  (1280 + 64 * (j))
#define XB_XGEN(j)  (2304 + 64 * (j))
#define XB_TOP      3328
#define XB_TOPGEN   3392
#define XCD_BAR_WORDS 3456
#define XB_SPIN_CAP (1u << 18)
__device__ __forceinline__ unsigned xb_ld(unsigned* p)              { return __hip_atomic_load(p, __ATOMIC_RELAXED, __HIP_MEMORY_SCOPE_AGENT); }
__device__ __forceinline__ unsigned xb_add(unsigned* p, unsigned v) { return __hip_atomic_fetch_add(p, v, __ATOMIC_RELAXED, __HIP_MEMORY_SCOPE_AGENT); }
__device__ __forceinline__ unsigned xb_xcc_id() { return (unsigned)__builtin_amdgcn_s_getreg((3 << 11) | 20) & 0xFu; }
#define XB_SPIN(cond, bar) do { unsigned _sp = 0; while (cond) { __builtin_amdgcn_s_sleep(1); \
    if ((++_sp & 255u) == 0u) { if (xb_ld(&(bar)[XB_TMO])) break; if (_sp > XB_SPIN_CAP) { atomicAdd(&(bar)[XB_TMO], 1u); break; } } } } while (0)
struct XcdBarrier { unsigned* bar; unsigned x; volatile LAS unsigned* st; };
__device__ __forceinline__ XcdBarrier xcd_barrier_post(unsigned* bar, volatile LAS unsigned* st) {
    XcdBarrier b; b.bar = bar; b.x = xb_xcc_id(); b.st = st;
    if (threadIdx.x == 0) (void)xb_add(&bar[XB_XCNT(b.x)], 1u);
    return b;
}
__device__ __forceinline__ void xcd_barrier_complete(unsigned* bar, unsigned x, unsigned& nloc, unsigned& nx) {
    const unsigned G = gridDim.x * gridDim.y * gridDim.z;
    unsigned sum, cnt, mine, sp = 0u;
    for (;;) {
        sum = 0u; cnt = 0u; mine = 0u;
#pragma unroll
        for (unsigned j = 0; j < 16; ++j) { const unsigned c = xb_ld(&bar[XB_XCNT(j)]); sum += c; cnt += (c > 0u) ? 1u : 0u; mine = (j == x) ? c : mine; }
        if (sum == G) break;
        __builtin_amdgcn_s_sleep(1);
        if ((++sp & 255u) == 0u) { if (xb_ld(&bar[XB_TMO])) break; if (sp > XB_SPIN_CAP) { atomicAdd(&bar[XB_TMO], 1u); break; } }
    }
    nloc = mine > 0u ? mine : 1u; nx = cnt > 0u ? cnt : 1u;
}
__device__ __forceinline__ void xcd_barrier(const XcdBarrier& b) {
    asm volatile("s_waitcnt vmcnt(0)" ::: "memory");
    __syncthreads();
    if (threadIdx.x == 0) {
        unsigned* bar = b.bar;
        __builtin_amdgcn_s_waitcnt(0);
        unsigned nloc = b.st[0], nx = b.st[1];
        if (nloc == 0u) { xcd_barrier_complete(bar, b.x, nloc, nx); b.st[0] = nloc; b.st[1] = nx; }
        const unsigned old = xb_add(&bar[XB_XSUB(b.x)], 1u);
        const unsigned gen = old / nloc;
        if (old + 1u == (gen + 1u) * nloc) {
            __builtin_amdgcn_fence(__ATOMIC_RELEASE, "agent");
            asm volatile("s_waitcnt vmcnt(0)" ::: "memory");
            const unsigned og = xb_add(&bar[XB_TOP], 1u);
            const unsigned tg = og / nx;
            if (og + 1u == (tg + 1u) * nx) xb_add(&bar[XB_TOPGEN], 1u);
            else XB_SPIN(xb_ld(&bar[XB_TOPGEN]) == tg, bar);
            __builtin_amdgcn_fence(__ATOMIC_ACQUIRE, "agent");
            xb_add(&bar[XB_XGEN(b.x)], 1u);
            asm volatile("s_waitcnt vmcnt(0)" ::: "memory");
        } else {
            XB_SPIN(xb_ld(&bar[XB_XGEN(b.x)]) == gen, bar);
            __builtin_amdgcn_fence(__ATOMIC_ACQUIRE, "agent");
            asm volatile("s_waitcnt vmcnt(0)" ::: "memory");
        }
    }
    __syncthreads();
}

constexpr int LDS_BYTES = 147456;
constexpr int MISC_OFF = 131072 + 320;
constexpr int CW_BAR = 4096;
constexpr int NPHASE = 9;
constexpr int TBL_OFF = 131072 + 512, CNTL_OFF = 131072 + 800, TILEE_OFF = 131072 + 1280;
__device__ __forceinline__ int moe_tables(LAS unsigned char* lds, const unsigned* ctl_, int tid) {
    LAS int* base = (LAS int*)(lds + TBL_OFF); LAS int* cl = (LAS int*)(lds + CNTL_OFF); LAS unsigned char* te = lds + TILEE_OFF;
    __syncthreads();
    if (tid < NE) cl[tid] = (int)ctl_[CW_CNT + tid];
    __syncthreads();
    if (tid == 0) { int acc = 0; for (int e = 0; e < NE; ++e) { base[e] = acc; acc += (cl[e] + 255) >> 8; } base[64] = acc; base[65] = acc + T / 256; }
    __syncthreads();
    const int nt = base[65];
    for (int i = tid; i < MAXTILES; i += 512) { int e = 0; if (i < nt) { while (base[e + 1] <= i) ++e; } te[i] = (unsigned char)e; }
    __syncthreads();
    return nt;
}
struct Args { const void* in[24]; float* out; unsigned char* ws; int ph_lo, ph_hi; };
static_assert(sizeof(Args) == 24 * 8 + 8 + 8 + 8, "Args has no padding");
template <int K_> __device__ __forceinline__ const void* inptr() { const void* p; const void* ka = (const void*)__builtin_amdgcn_kernarg_segment_ptr();
    asm volatile("s_load_dwordx2 %0, %1, %2\n\ts_waitcnt lgkmcnt(0)" : "=s"(p) : "s"(ka), "i"(K_ * 8) : "memory");
    return p; }
__device__ __forceinline__ int fresh_tid() { int t = threadIdx.x; asm volatile("" : "+v"(t)); return t; }
__device__ __forceinline__ int fresh_bid() { int b = blockIdx.x; asm volatile("" : "+s"(b)); return b; }
#define x_ ((gfp)inptr<0>())
#define positions_  ((gip)inptr<1>())
#define w_in_ ((gfp)inptr<2>())
#define b_gate_ ((gfp)inptr<3>())
#define q_norm_g_ ((gfp)inptr<4>())
#define kv_norm_g_ ((gfp)inptr<5>())
#define w_uq_ ((gfp)inptr<6>())
#define w_uk_ ((gfp)inptr<7>())
#define w_uv_ ((gfp)inptr<8>())
#define swa_sinks_ ((gfp)inptr<9>())
#define rel_table_ ((gfp)inptr<10>())
#define w_br_mla_ ((gfp)inptr<11>())
#define w_br_swa_ ((gfp)inptr<12>())
#define w_out_ ((gfp)inptr<13>())
#define ln1_g_ ((gfp)inptr<14>())
#define ln1_b_ ((gfp)inptr<15>())
#define w_router_ ((gfp)inptr<16>())
#define router_bias_ ((gfp)inptr<17>())
#define w_gate_up_ ((gfp)inptr<18>())
#define w_down_ ((gfp)inptr<19>())
#define w_sgu_ ((gfp)inptr<20>())
#define w_sdn_ ((gfp)inptr<21>())
#define ln2_g_ ((gfp)inptr<22>())
#define ln2_b_ ((gfp)inptr<23>())
#define ctl      ((unsigned*)(ws + OFF_CTL))
#define ropec    ((float*)(ws + OFF_ROPEC))
#define ropes    ((float*)(ws + OFF_ROPES))
#define ssq      ((float*)(ws + OFF_SSQ))
#define topw     ((float*)(ws + OFF_TOPKW))
#define elist    ((int*)(ws + OFF_LIST))
#define dlist    ((int*)(ws + OFF_DLIST))
#define WRH      ((bf16_t*)(ws + OFF_WR))
#define WRL      (((bf16_t*)(ws + OFF_WR)) + NE * DM)
#define WUQ      ((bf16_t*)(ws + OFF_WUQ))
#define WUKV     ((bf16_t*)(ws + OFF_WUKV))
#define WBR      ((bf16_t*)(ws + OFF_WBR))
#define WOUT     ((bf16_t*)(ws + OFF_WOUT))
#define WIN      ((bf16_t*)(ws + OFF_WIN))
#define WDN      ((bf16_t*)(ws + OFF_WDN))
#define WGU      ((bf16_t*)(ws + OFF_WGU))
#define HB       ((bf16_t*)(ws + OFF_HB))
#define HB8      ((unsigned char*)(ws + OFF_HB8))
#define ACT      ((bf16_t*)(ws + OFF_ACT))
#define XB       ((bf16_t*)(ws + OFF_XB))
#define CQ       ((bf16_t*)(ws + OFF_CQ))
#define CKV      ((bf16_t*)(ws + OFF_CKV))
#define QS       ((bf16_t*)(ws + OFF_QS))
#define KS       ((bf16_t*)(ws + OFF_KS))
#define VS       ((bf16_t*)(ws + OFF_VS))
#define KR       ((bf16_t*)(ws + OFF_KR))
#define RT       ((bf16_t*)(ws + OFF_RT))
#define G1       ((bf16_t*)(ws + OFF_G1))
#define Q        ((bf16_t*)(ws + OFF_Q))
#define KN       ((bf16_t*)(ws + OFF_KN))
#define VM       ((bf16_t*)(ws + OFF_VM))
#define O        ((bf16_t*)(ws + OFF_O))
#define MG       ((bf16_t*)(ws + OFF_MG))
#define HPRE     ((bf16_t*)(ws + OFF_HPRE))
#define Y        ((bf16_t*)(ws + OFF_Y))
#define PHASE_IDS() const int tid = fresh_tid(), bid = fresh_bid(); const int lane = tid & 63, wave = __builtin_amdgcn_readfirstlane(tid >> 6); \
    const int vtid = tid & 255, vb0 = bid * 2 + (tid >> 8), nvb = G * 2, gw = bid * 8 + wave, NGW = G * 8; (void)lane; (void)wave; (void)vtid; (void)vb0; (void)nvb; (void)gw; (void)NGW

__global__ void __launch_bounds__(512, 2) mega(Args args) {
    extern __shared__ __attribute__((aligned(16))) unsigned char lds_raw[];
    LAS unsigned char* lds = (LAS unsigned char*)lds_raw;
    const int G = gridDim.x;
    unsigned char* ws = args.ws; float* out = args.out;
    { const int tid = threadIdx.x;
    for (int u = tid; u < (LDS_BYTES - 131072) / 4; u += 512) ((LAS unsigned*)(lds + 131072))[u] = 0u;
    __syncthreads(); }
    const XcdBarrier bar = xcd_barrier_post(ctl + CW_BAR, (volatile LAS unsigned*)(lds + MISC_OFF) + 8);
    const int lo = args.ph_lo, hi = args.ph_hi & 0xffff, variant = args.ph_hi >> 16; (void)variant;
#ifndef ONLY_PHASE
#define ONLY_PHASE -1
#endif
#define IN(k) ((ONLY_PHASE < 0 || ONLY_PHASE == (k)) && lo <= (k) && (k) < hi)
#define SEAM(k) do { if (IN(k) && IN((k) + 1)) xcd_barrier(bar); } while (0)

    if (IN(0)) { PHASE_IDS();
        LAS unsigned char* scr = lds + wave * 8192;
#define TRANSPOSE(Map, W_, K_, Nsrc_, WT_, Nout_, ldo_, koff_, ks_, Z_, wstride_, ostride_) do { const int per_ = ((K_) / 64) * ((Nout_) / 64), n_ = per_ * (Z_); \
        for (int it = gw; it < n_; it += NGW) { const int z_ = it / per_; transpose_item<Map>((W_) + (size_t)z_ * (wstride_), K_, Nsrc_, (WT_) + (size_t)z_ * (ostride_), Nout_, ldo_, koff_, ks_, scr, it % per_, lane); } } while (0)
        if (PROJ_FP8) { for (int it = gw; it < (DM / 64) * (NPROJ / 64); it += NGW) transpose_item8<MapWin>(w_in_, DM, 6464, (unsigned char*)WIN, NPROJ, DM, 0, W8_SCALE, scr, it, lane); }
        else if (!GATE_FP8) TRANSPOSE(MapWin, w_in_, DM, 6464, WIN, NPROJ, DM, 0, (gfp)nullptr, 1, 0, 0);
        else TRANSPOSE(MapWinA, w_in_, DM, 6464, WIN, 2560, DM, 0, (gfp)nullptr, 1, 0, 0);
#define TRANSPOSE8(Map, W_, K_, Nsrc_, WT_, Nout_, Z_, wstride_, ostride_) do { const int per_ = ((K_) / 64) * ((Nout_) / 64), n_ = per_ * (Z_); \
        for (int it = gw; it < n_; it += NGW) { const int z_ = it / per_; transpose_item8<Map>((W_) + (size_t)z_ * (wstride_), K_, Nsrc_, (unsigned char*)(WT_) + (size_t)z_ * (ostride_), Nout_, K_, 0, W8_SCALE, scr, it % per_, lane); } } while (0)
#define TPIPE8(Map, W_, K_, Nsrc_, WT_, Nout_, Z_, wstride_, ostride_) do { const int per_ = ((K_) / 64) * ((Nout_) / 64), n_ = per_ * (Z_); f32x4 va_[16], vb_[16]; \
        int it_ = gw; if (it_ < n_) t8_load<Map>((W_) + (size_t)(it_ / per_) * (wstride_), Nsrc_, Nout_, it_ % per_, lane, va_); \
        for (; it_ < n_; it_ += 2 * NGW) { const int i1_ = it_ + NGW, i2_ = it_ + 2 * NGW; \
            if (i1_ < n_) t8_load<Map>((W_) + (size_t)(i1_ / per_) * (wstride_), Nsrc_, Nout_, i1_ % per_, lane, vb_); \
            t8_proc(va_, (unsigned char*)(WT_) + (size_t)(it_ / per_) * (ostride_), Nout_, K_, W8_SCALE, scr, it_ % per_, lane); \
            if (i1_ < n_) { if (i2_ < n_) t8_load<Map>((W_) + (size_t)(i2_ / per_) * (wstride_), Nsrc_, Nout_, i2_ % per_, lane, va_); \
                t8_proc(vb_, (unsigned char*)(WT_) + (size_t)(i1_ / per_) * (ostride_), Nout_, K_, W8_SCALE, scr, i1_ % per_, lane); } } } while (0)
        if (GATE_FP8 && !PROJ_FP8) TRANSPOSE8(MapWinG, w_in_, DM, 6464, (unsigned char*)WIN + (size_t)2560 * DM * 2, 4096, 1, 0, 0);
        if (MOE_FP8 && NE_GU0 > 0 && !(variant & 16)) TPIPE8(MapGU, w_gate_up_, DM, 1024, WGU, 1024, NE_GU0, (size_t)DM * 1024, (size_t)1024 * DM);
        if (!MOE_FP8) {
        TRANSPOSE(MapGU, w_gate_up_, DM, 1024, WGU, 1024, DM, 0, (gfp)nullptr, NE, (size_t)DM * 1024, (size_t)1024 * DM);
        TRANSPOSE(MapGU, w_sgu_, DM, 1024, WGU + (size_t)NE * 1024 * DM, 1024, DM, 0, (gfp)nullptr, 1, 0, 0);
        TRANSPOSE(MapId, w_down_, FF, DM, WDN, DM, FF, 0, (gfp)nullptr, NE, (size_t)FF * DM, (size_t)DM * FF);
        TRANSPOSE(MapId, w_sdn_, FF, DM, WDN + (size_t)NE * DM * FF, DM, FF, 0, (gfp)nullptr, 1, 0, 0);
        }
        if (!(variant & 32)) { gfp xp = x_; bf16_t* xb = XB; const size_t NTH = (size_t)G * 512, t0 = (size_t)bid * 512 + tid;
          for (size_t e = t0; e < (size_t)T * DM / 8; e += 4 * NTH) { f32x4 a[4], b[4];
#pragma unroll
              for (int u = 0; u < 4; ++u) { const size_t i = (e + u * NTH) * 8; if (i < (size_t)T * DM) { a[u] = __builtin_nontemporal_load((const GAS f32x4*)(xp + i)); b[u] = __builtin_nontemporal_load((const GAS f32x4*)(xp + i + 4)); } }
#pragma unroll
              for (int u = 0; u < 4; ++u) { const size_t i = (e + u * NTH) * 8; if (i < (size_t)T * DM) { if (!PROJ_FP8) *(u32x4*)(xb + i) = pg8::pack8(a[u], b[u]);
                  if (GATE_FP8 || PROJ_FP8) { u32x2 p8; p8.x = pack4_fp8_(a[u] * H8_SCALE); p8.y = pack4_fp8_(b[u] * H8_SCALE); *(u32x2*)(HB8 + i) = p8; } } } } }
        for (int vb = vb0; vb < T * 32 / 256; vb += nvb) b_rope_table(vb, vtid, positions_, ropec, ropes);
    }
    SEAM(0);
    if (IN(1)) { PHASE_IDS();
        const int GG = (G == 256 && MOE_FP8) ? CONV_SPLIT : G;
#define CONV_ALL() do { LAS unsigned char* scr = lds + wave * 8192; \
            conv_dynamic<MapGU>(w_gate_up_, w_sgu_, DM, 1024, (unsigned char*)WGU, ctl + CW_CONV, scr, lane); \
            conv_dynamic<MapId>(w_down_, w_sdn_, FF, DM, (unsigned char*)WDN, ctl + CW_CONV + 32, scr, lane); } while (0)
        if (bid < GG && !(variant & 64)) {
        if (PROJ_FP8) { pg8::Gemm g{HB8, WIN, {}, DM, (variant >> 1) & 7, E8_ACT, E8_W}; pg8::StaticOrder S; S.init(T, NPROJ, DM, GG, bid); pg8::FProj e{CQ, CKV, QS, KS, VS, KR, RT, G1, b_gate_, ropec, ropes, ssq, 0}; pg8::gemm_phase<false, 1>(lds, g, S, e); }
        else if (!GATE_FP8) { pg8::Gemm g{XB, WIN, {}, DM, (variant >> 1) & 7, 0u, 0u}; pg8::StaticOrder S; S.init(T, NPROJ, DM, G, bid); pg8::FProj e{CQ, CKV, QS, KS, VS, KR, RT, G1, b_gate_, ropec, ropes, ssq, 0}; pg8::gemm_phase<false, 2>(lds, g, S, e); }
        else {
            { pg8::Gemm g{XB, WIN, {}, DM, (variant >> 1) & 7, 0u, 0u}; pg8::StaticOrder S; S.init(T, 2560, DM, G, bid); pg8::FProj e{CQ, CKV, QS, KS, VS, KR, RT, G1, b_gate_, ropec, ropes, ssq, 1}; pg8::gemm_phase<false, 2>(lds, g, S, e); }
            { pg8::Gemm g{HB8, (unsigned char*)WIN + (size_t)2560 * DM * 2, {}, DM, (variant >> 1) & 7, E8_ACT, E8_W}; pg8::StaticOrder S; S.init(T, 4096, DM, G, bid); pg8::FProj e{CQ, CKV, QS, KS, VS, KR, RT, G1, b_gate_, ropec, ropes, ssq, 2}; pg8::gemm_phase<false, 1>(lds, g, S, e); }
        }
        __syncthreads(); }
#if CONV_DYNAMIC
        if (MOE_FP8 && !(variant & 16)) CONV_ALL(); }
#else
        if (MOE_FP8 && !(variant & 16) && (bid >= GG || GG == G)) { LAS unsigned char* scr = lds + wave * 8192; const int gwc_ = GG == G ? gw : (bid - GG) * 8 + wave, ngwc_ = GG == G ? NGW : (G - GG) * 8;
            { const int gw = gwc_, NGW = ngwc_;
        TRANSPOSE(MapWuq, w_uq_, QR, 1536, WUQ, 1536, QR, 0, q_norm_g_, 1, 0, 0);
        TRANSPOSE(MapId, w_uk_, KVR, 1024, WUKV, 1024, KVR, 0, kv_norm_g_, 1, 0, 0);
        TRANSPOSE(MapId, w_uv_, KVR, 1024, WUKV + 1024 * KVR, 1024, KVR, 0, kv_norm_g_, 1, 0, 0);
        if (!MERGE_FP8) {
        TRANSPOSE(MapId, w_br_mla_, 1024, DM, WBR, DM, DM, 0, (gfp)nullptr, 1, 0, 0);
        TRANSPOSE(MapId, w_br_swa_, 1024, DM, WBR, DM, DM, 1024, (gfp)nullptr, 1, 0, 0);
        } else {
            for (int it = gw; it < 16 * 32; it += NGW) transpose_item8<MapId>(w_br_mla_, 1024, DM, (unsigned char*)WBR, DM, DM, 0, W8_SCALE, scr, it, lane);
            for (int it = gw; it < 16 * 32; it += NGW) transpose_item8<MapId>(w_br_swa_, 1024, DM, (unsigned char*)WBR, DM, DM, 1024, W8_SCALE, scr, it, lane);
        }
        if (!MIX_FP8) TRANSPOSE(MapId, w_out_, DM, DM, WOUT, DM, DM, 0, (gfp)nullptr, 1, 0, 0);
        else { for (int it = gw; it < 32 * 32; it += NGW) transpose_item8<MapId>(w_out_, DM, DM, (unsigned char*)WOUT, DM, DM, 0, WOUT8_SCALE, scr, it, lane); }
            { const int vb0c_ = GG == G ? vb0 : (bid - GG) * 2 + (tid >> 8), nvbc_ = GG == G ? nvb : (G - GG) * 2; for (int vb = vb0c_; vb < NE * DM / 256; vb += nvbc_) b_router_split(vb, vtid, w_router_, WRH, WRL); }
            conv_pairs3<MapGU>(w_gate_up_ + (size_t)NE_GU0 * DM * 1024, (size_t)DM * 1024, 1024, (unsigned char*)WGU + (size_t)NE_GU0 * 1024 * DM, (size_t)1024 * DM, 1024, DM, NE - NE_GU0, gw, NGW, scr, lane);
            TRANSPOSE8(MapGU, w_sgu_, DM, 1024, (unsigned char*)WGU + (size_t)NE * 1024 * DM, 1024, 1, 0, 0);
            conv_pairs3<MapId>(w_down_, (size_t)FF * DM, DM, (unsigned char*)WDN, (size_t)DM * FF, DM, FF, NE, gw, NGW, scr, lane);
            TRANSPOSE8(MapId, w_sdn_, FF, DM, (unsigned char*)WDN + (size_t)NE * DM * FF, DM, 1, 0, 0); } } }
#endif
#undef CONV_ALL
#undef TRANSPOSE8
#undef TPIPE8
#undef TRANSPOSE
    SEAM(1);
    if (IN(2)) { PHASE_IDS();
        { pg8::Gemm g{CQ, WUQ, {}, QR, (variant >> 1) & 7, 0u, 0u}; pg8::StaticOrder S; S.init(T, 1536, QR, G, bid); pg8::FQ e{Q, ssq, ropec, ropes}; pg8::gemm_phase<false, 2>(lds, g, S, e); }
        { pg8::Gemm g{CKV, WUKV, {}, KVR, (variant >> 1) & 7, 0u, 0u}; pg8::StaticOrder S; S.init(T, 2048, KVR, G, bid); pg8::FKV e{KN, VM, ssq}; pg8::gemm_phase<false, 2>(lds, g, S, e); }
    }
    SEAM(2);
    if (IN(3)) { PHASE_IDS();
        #ifdef MLA_PF
        if (variant >> 4) att::mla_phase<MLA_PF>(lds, Q, KN, KR, VM, O, G, bid); else
#endif
        if (!(variant & 4)) att::mla_phase<0>(lds, Q, KN, KR, VM, O, G, bid);
        if (!(variant & 8)) att::swa_phase(lds, QS, KS, VS, swa_sinks_, rel_table_, O, G, bid);
    }
    SEAM(3);
    if (IN(4)) { PHASE_IDS(); pg8::StaticOrder S; S.init(T, DM, DM, G, bid); pg8::FMerge e{RT, G1, MG};
        if (MERGE_FP8) { pg8::Gemm g{O, WBR, {}, DM, (variant >> 1) & 7, E8_W, E8_W}; pg8::gemm_phase<false, 1>(lds, g, S, e); }
        else { pg8::Gemm g{O, WBR, {}, DM, (variant >> 1) & 7, 0u, 0u}; pg8::gemm_phase<false, 2>(lds, g, S, e); } }
    SEAM(4);
    if (IN(5)) { PHASE_IDS(); pg8::StaticOrder S; S.init(T, DM, DM, G, bid); pg8::FOut e{x_, HPRE};
        if (MIX_FP8) { pg8::Gemm g{MG, WOUT, {}, DM, (variant >> 1) & 7, E8_W, E8_W}; pg8::gemm_phase<false, 1>(lds, g, S, e); }
        else { pg8::Gemm g{MG, WOUT, {}, DM, (variant >> 1) & 7, 0u, 0u}; pg8::gemm_phase<false, 2>(lds, g, S, e); } }
    SEAM(5);
    if (IN(6)) { PHASE_IDS(); lnr::phase(lds, HPRE, ln1_g_, ln1_b_, WRH, WRL, router_bias_, HB, HB8, topw, elist, dlist, ctl + CW_CNT, G, bid); }
    SEAM(6);
    if (IN(7)) { PHASE_IDS(); const int ntl = moe_tables(lds, ctl, tid); const pg8::MoeMap mm{elist, (const LAS int*)(lds + TBL_OFF), (const LAS int*)(lds + CNTL_OFF), lds + TILEE_OFF};
        pg8::MoeOrder S{ntl, 4, G, bid, DM, (size_t)1024 * DM, lds + TILEE_OFF};
        if (MOE_FP8) { pg8::Gemm g{HB8, WGU, mm, DM, (variant >> 1) & 7, E8_ACT, E8_W}; pg8::FGU8 e{(unsigned char*)ACT}; pg8::gemm_phase<true, 1>(lds, g, S, e); }
        else { pg8::Gemm g{HB, WGU, mm, DM, (variant >> 1) & 7, 0u, 0u}; pg8::FGU e{ACT}; pg8::gemm_phase<true, 2>(lds, g, S, e); } }
    SEAM(7);
    if (IN(8)) { PHASE_IDS(); const int ntl = moe_tables(lds, ctl, tid); const pg8::MoeMap mm{dlist, (const LAS int*)(lds + TBL_OFF), (const LAS int*)(lds + CNTL_OFF), lds + TILEE_OFF};
        pg8::MoeOrder S{ntl, 8, G, bid, FF, (size_t)DM * FF, lds + TILEE_OFF}; pg8::FDown e{Y, mm, variant & 1};
        if (MOE_FP8) { pg8::Gemm g{ACT, WDN, {}, FF, (variant >> 1) & 7, Y_FP8 ? E8_ACTY : E8_ACT, E8_W}; pg8::gemm_phase<false, 1>(lds, g, S, e); }
        else { pg8::Gemm g{ACT, WDN, {}, FF, (variant >> 1) & 7, 0u, 0u}; pg8::gemm_phase<false, 2>(lds, g, S, e); } }
    SEAM(8);
    if (IN(9)) { PHASE_IDS(); if (Y_FP8) final_phase8(HB, (const unsigned char*)Y, topw, ln2_g_, ln2_b_, out, gw, NGW, lane); else final_phase(HB, Y, topw, ln2_g_, ln2_b_, out, gw, NGW, lane); }
#undef IN
#undef SEAM
}

#undef x_
#undef ctl
#undef O
#undef Q
#undef Y
extern "C" void kernel_launch(void* const* d_in, const int* in_sizes, int n_in, void* d_out, int out_size, void* d_ws, size_t ws_size, hipStream_t stream) {
    static int grid = 0;
    if (grid == 0) {
        if (n_in != 24 || out_size != T * DM || ws_size < WS_NEED) { fprintf(stderr, "kernel_launch: unexpected problem (n_in %d, out %d, ws %zu < %zu)\n", n_in, out_size, ws_size, (size_t)WS_NEED); grid = -1; return; }
        int dev = 0, cus = 0;
        if (hipGetDevice(&dev) != hipSuccess || hipDeviceGetAttribute(&cus, hipDeviceAttributeMultiprocessorCount, dev) != hipSuccess) { grid = -1; return; }
        if (hipFuncSetAttribute((const void*)mega, hipFuncAttributeMaxDynamicSharedMemorySize, LDS_BYTES) != hipSuccess) { fprintf(stderr, "kernel_launch: hipFuncSetAttribute failed\n"); grid = -1; return; }
        int per_cu = 0;
        if (hipOccupancyMaxActiveBlocksPerMultiprocessor(&per_cu, (const void*)mega, 512, LDS_BYTES) != hipSuccess || per_cu < 1) fprintf(stderr, "kernel_launch: occupancy query reports %d\n", per_cu);
        (void)hipGetLastError();
        grid = cus;
    }
    if (grid < 0) return;
    (void)hipMemsetAsync((char*)d_ws + OFF_CTL, 0, 1 * MiB, stream);
    Args a; memset(&a, 0, sizeof(a));
    for (int i = 0; i < 24; ++i) a.in[i] = d_in[i];
    a.out = (float*)d_out; a.ws = (unsigned char*)d_ws; a.ph_lo = 0; a.ph_hi = NPHASE + 1;
    hipLaunchKernelGGL(mega, dim3(grid), dim3(512), LDS_BYTES, stream, a);
#ifdef PROBE_PHASE
#ifndef PROBE_VARIANT
#define PROBE_VARIANT 0
#endif
    a.ph_lo = PROBE_PHASE; a.ph_hi = (PROBE_PHASE + 1) | (PROBE_VARIANT << 16);
    hipLaunchKernelGGL(mega, dim3(grid), dim3(512), LDS_BYTES, stream, a);
#endif
}
```
